# Optimizing an MI355X kernel written in HIP

```python
import jax
import jax.numpy as jnp
from jax import lax
import numpy as np

D_MODEL = 2048
BATCH = 8
SEQ = 4096
DEPTH = 4

GRID_W = 64
CTX_LEN = 256
EPS = 1e-6
NEG_BIG = -1e30
LB_FLOOR = 1e-30

A_WIDTH = D_MODEL // 4
A_GROUPS = 4
A_GROUP_DIM = A_WIDTH // A_GROUPS
A_CHUNK = 128

B_WIDTH = D_MODEL // 2
B_HEADS = 4
B_HEAD_DIM = B_WIDTH // B_HEADS
B_CHUNK = 128
CONV_W = 3

C_WIDTH = D_MODEL // 4
C_HEADS = 4
C_KEY_DIM = 128
C_KEY_WIDTH = C_HEADS * C_KEY_DIM
C_VAL_DIM = C_WIDTH // C_HEADS
C_CHUNK = 64

D_MIX = A_WIDTH + B_WIDTH + C_WIDTH
FORGET_BIAS_LO = 3.0
FORGET_BIAS_HI = 6.0

IN_LAYOUT = (
    ('a_u', A_WIDTH), ('a_v', A_WIDTH), ('a_z', A_WIDTH),
    ('b_q', B_WIDTH), ('b_k', B_WIDTH), ('b_v', B_WIDTH), ('b_o', B_WIDTH), ('b_z', B_WIDTH),
    ('b_i_fwd', B_HEADS), ('b_f_fwd', B_HEADS), ('b_i_bwd', B_HEADS), ('b_f_bwd', B_HEADS),
    ('c_q', C_KEY_WIDTH), ('c_f_fwd', C_KEY_WIDTH), ('c_f_bwd', C_KEY_WIDTH), ('c_i', C_WIDTH), ('c_g', C_WIDTH),
)
D_IN = sum(w for _, w in IN_LAYOUT)

kernel_name = 'hybrid_ctx_prefix_chunkmlp_mlstm_hgrn2'


def _col_start(name):
    start = 0
    for n, w in IN_LAYOUT:
        if n == name:
            return start
        start += w
    raise ValueError(name)


def _split_cols(p):
    out = {}
    start = 0
    for name, w in IN_LAYOUT:
        out[name] = p[..., start:start + w]
        start += w
    return out


def _rmsnorm(x, g):
    xf = x.astype(jnp.float32)
    y = xf * lax.rsqrt(jnp.mean(xf * xf, axis=-1, keepdims=True) + EPS)
    return (y * g.astype(jnp.float32)).astype(x.dtype)


def _head_rmsnorm(x, g, n_heads):
    b, t, w = x.shape
    xh = x.reshape(b, t, n_heads, w // n_heads).astype(jnp.float32)
    xh = xh * lax.rsqrt(jnp.mean(xh * xh, axis=-1, keepdims=True) + EPS)
    return (xh.reshape(b, t, w) * g.astype(jnp.float32)).astype(x.dtype)


def _to_heads(x, n_heads):
    b, t, w = x.shape
    return x.reshape(b, t, n_heads, w // n_heads).transpose(0, 2, 1, 3)


def _from_heads(x):
    b, h, t, d = x.shape
    return x.transpose(0, 2, 1, 3).reshape(b, t, h * d)


def _to_colmajor(x, rows):
    b, t, ch = x.shape
    return x.reshape(b, rows, GRID_W, ch).transpose(0, 2, 1, 3).reshape(b, t, ch)


def _from_colmajor(x, rows):
    b, t, ch = x.shape
    return x.reshape(b, GRID_W, rows, ch).transpose(0, 2, 1, 3).reshape(b, t, ch)


def _conv_centred(x, w):
    pad = CONV_W // 2
    t = x.shape[1]
    xp = jnp.pad(x, ((0, 0), (pad, pad), (0, 0)))
    out = w[0] * xp[:, 0:t]
    for j in range(1, CONV_W):
        out = out + w[j] * xp[:, j:j + t]
    return out


def _chunk_mlp(u, v, z, w_s, b_s):
    b, t, _ = v.shape
    n = t // A_CHUNK
    vf = v.astype(jnp.float32).reshape(b, n, A_CHUNK, A_GROUPS, A_GROUP_DIM)
    mu = jnp.mean(vf, axis=-1, keepdims=True)
    var = jnp.mean(jnp.square(vf - mu), axis=-1, keepdims=True)
    vn = ((vf - mu) * lax.rsqrt(var + EPS)).astype(v.dtype)
    mixed = jnp.einsum('gts,bnsgc->bntgc', w_s, vn) + b_s.T[:, :, None]
    return u * mixed.reshape(b, t, A_WIDTH) * jax.nn.silu(z)


def _mlstm_zero_state(b):
    return (jnp.zeros((b, B_HEADS, B_HEAD_DIM, B_HEAD_DIM), jnp.float32),
            jnp.zeros((b, B_HEADS, B_HEAD_DIM), jnp.float32),
            jnp.zeros((b, B_HEADS), jnp.float32))


def _mlstm_dir(q, k, v, ig, lf, state):
    b, h, t, d = q.shape
    L = B_CHUNK
    nc = t // L
    mask = jnp.tril(jnp.ones((L, L), bool))

    def chunks(a):
        return jnp.moveaxis(a.reshape((b, h, nc, L) + a.shape[3:]), 2, 0)

    def step(carry, inp):
        C, n, m = carry
        qc, kc, vc, ic, fc = (a.astype(jnp.float32) for a in inp)
        cb = jnp.cumsum(fc, axis=-1)
        dmat = jnp.where(mask, cb[..., :, None] - cb[..., None, :] + ic[..., None, :], NEG_BIG)
        inter = cb + m[..., None]
        mt = jnp.maximum(inter, jnp.max(dmat, axis=-1))
        scores = jnp.einsum('bhtd,bhsd->bhts', qc, kc) * jnp.exp(dmat - mt[..., None])
        e_inter = jnp.exp(inter - mt)
        num = jnp.einsum('bhts,bhse->bhte', scores, vc) + e_inter[..., None] * jnp.einsum('bhtd,bhde->bhte', qc, C)
        den = jnp.sum(scores, axis=-1) + e_inter * jnp.einsum('bhtd,bhd->bht', qc, n)
        hc = num / jnp.maximum(jnp.abs(den), jnp.exp(-mt))[..., None]
        cl = cb[..., -1]
        w_log = cl[..., None] - cb + ic
        m_new = jnp.maximum(cl + m, jnp.max(w_log, axis=-1))
        ws = jnp.exp(w_log - m_new[..., None])
        ec = jnp.exp(cl + m - m_new)
        C_new = ec[..., None, None] * C + jnp.einsum('bhs,bhsd,bhse->bhde', ws, kc, vc)
        n_new = ec[..., None] * n + jnp.einsum('bhs,bhsd->bhd', ws, kc)
        return (C_new, n_new, m_new), hc.astype(v.dtype)

    state, hs = lax.scan(step, state, tuple(chunks(a) for a in (q, k, v, ig, lf)))
    return jnp.moveaxis(hs, 0, 2).reshape(b, h, t, d), state


def _hgrn_dir(q, k, v, lf, S):
    b, h, t, dk = q.shape
    dv = v.shape[-1]
    L = C_CHUNK
    nc = t // L
    mask = jnp.tril(jnp.ones((L, L), bool))[:, :, None]

    def chunks(a):
        return jnp.moveaxis(a.reshape(b, h, nc, L, a.shape[-1]), 2, 0)

    def step(S, inp):
        qc, kc, vc, fc = (a.astype(jnp.float32) for a in inp)
        cb = jnp.cumsum(fc, axis=2)
        decay = jnp.exp(jnp.where(mask, cb[:, :, :, None, :] - cb[:, :, None, :, :], NEG_BIG))
        scores = jnp.einsum('bhtc,bhsc,bhtsc->bhts', qc, kc, decay)
        o = jnp.einsum('bhts,bhse->bhte', scores, vc) + jnp.einsum('bhtc,bhce->bhte', qc * jnp.exp(cb), S)
        cl = cb[:, :, -1:, :]
        S_new = jnp.exp(cl[:, :, 0, :])[..., None] * S + jnp.einsum('bhsc,bhse->bhce', kc * jnp.exp(cl - cb), vc)
        return S_new, o.astype(q.dtype)

    S, os_ = lax.scan(step, S, tuple(chunks(a) for a in (q, k, v, lf)))
    return jnp.moveaxis(os_, 0, 2).reshape(b, h, t, dv), S


def _mlstm_branch(pc, pl, conv_w, norm_g, last):
    def prep(p):
        qk = jax.nn.silu(_conv_centred(jnp.concatenate([p['b_q'], p['b_k']], axis=-1), conv_w))
        q = _to_heads(qk[..., :B_WIDTH], B_HEADS)
        k = _to_heads(qk[..., B_WIDTH:], B_HEADS) * (B_HEAD_DIM ** -0.5)
        v = _to_heads(p['b_v'], B_HEADS)
        gate = lambda name: jnp.swapaxes(p[name].astype(jnp.float32), 1, 2)
        fl = lambda a: jnp.flip(a, 2)
        fwd = (q, k, v, gate('b_i_fwd'), jax.nn.log_sigmoid(gate('b_f_fwd')))
        bwd = (fl(q), fl(k), fl(v), fl(gate('b_i_bwd')), fl(jax.nn.log_sigmoid(gate('b_f_bwd'))))
        return fwd, bwd

    ctx_f, ctx_b = prep(pc)
    lat_f, lat_b = prep(pl)
    s0 = _mlstm_zero_state(pl['b_q'].shape[0])
    hcf, scf = _mlstm_dir(*ctx_f, s0)
    hcb, scb = _mlstm_dir(*ctx_b, s0)
    hlf, _ = _mlstm_dir(*lat_f, scf)
    hlb, _ = _mlstm_dir(*lat_b, scb)

    def readout(hf, hb_rev, p):
        hsum = _from_heads(hf + jnp.flip(hb_rev, 2))
        return _head_rmsnorm(hsum, norm_g, B_HEADS) * jax.nn.sigmoid(p['b_o']) * jax.nn.silu(p['b_z'])

    y_lat = readout(hlf, hlb, pl)
    y_ctx = None if last else readout(hcf, hcb, pc)
    return y_ctx, y_lat


def _hgrn_branch(pc, pl, rows, lb, norm_g, last):
    lb_h = lb.reshape(C_HEADS, 1, C_KEY_DIM)
    log_lb = jnp.log(jnp.maximum(lb_h, LB_FLOOR))
    log_1m_lb = jnp.log1p(-lb_h)

    def gate(logit):
        z = _to_heads(logit, C_HEADS).astype(jnp.float32)
        return (1.0 - lb_h) * jax.nn.sigmoid(-z), jnp.logaddexp(log_lb, log_1m_lb + jax.nn.log_sigmoid(z))

    def prep(p, order):
        q = _to_heads(jax.nn.silu(order(p['c_q'])), C_HEADS)
        v = _to_heads(order(p['c_i']), C_HEADS)
        kf, lff = gate(order(p['c_f_fwd']))
        kb, lfb = gate(order(p['c_f_bwd']))
        fl = lambda a: jnp.flip(a, 2)
        return (q, kf, v, lff), (fl(q), fl(kb), fl(v), fl(lfb))

    ident = lambda a: a
    ctx_f, ctx_b = prep(pc, ident)
    lat_f, lat_b = prep(pl, lambda a: _to_colmajor(a, rows))
    S0 = jnp.zeros((pl['c_q'].shape[0], C_HEADS, C_KEY_DIM, C_VAL_DIM), jnp.float32)
    ocf, scf = _hgrn_dir(*ctx_f, S0)
    ocb, scb = _hgrn_dir(*ctx_b, S0)
    olf, _ = _hgrn_dir(*lat_f, scf)
    olb, _ = _hgrn_dir(*lat_b, scb)

    def readout(of, ob_rev, p, unorder):
        o = unorder(_from_heads(of + jnp.flip(ob_rev, 2)))
        return _head_rmsnorm(o, norm_g, C_HEADS) * jax.nn.silu(p['c_g'])

    y_lat = readout(olf, olb, pl, lambda a: _from_colmajor(a, rows))
    y_ctx = None if last else readout(ocf, ocb, pc, ident)
    return y_ctx, y_lat


def _mixer(hc, hl, rows, w_in, b_in, w_s, b_s, conv_w, m_norm, lb, h_norm, w_out, last):
    pc = _split_cols(hc @ w_in + b_in)
    pl = _split_cols(hl @ w_in + b_in)
    ya_l = _chunk_mlp(pl['a_u'], pl['a_v'], pl['a_z'], w_s, b_s)
    yb_c, yb_l = _mlstm_branch(pc, pl, conv_w, m_norm, last)
    yc_c, yc_l = _hgrn_branch(pc, pl, rows, lb, h_norm, last)
    y_lat = jnp.concatenate([ya_l, yb_l, yc_l], axis=-1) @ w_out
    if last:
        return None, y_lat
    ya_c = _chunk_mlp(pc['a_u'], pc['a_v'], pc['a_z'], w_s, b_s)
    y_ctx = jnp.concatenate([ya_c, yb_c, yc_c], axis=-1) @ w_out
    return y_ctx, y_lat


def setup_inputs(seed: int = 0) -> dict:
    key = jax.random.key(seed)
    ks = jax.random.split(key, 20)
    nrm = jax.random.normal
    x = nrm(ks[0], (BATCH, SEQ, D_MODEL), jnp.float32)
    c = nrm(ks[1], (BATCH, D_MODEL), jnp.float32)
    ctx = nrm(ks[2], (BATCH, CTX_LEN, D_MODEL), jnp.float32)
    c_ctx = nrm(ks[3], (D_MODEL,), jnp.float32)
    w_ada = nrm(ks[4], (DEPTH, D_MODEL, 3 * D_MODEL), jnp.float32) * (0.5 * D_MODEL ** -0.5)
    b_ada = 0.02 * nrm(ks[5], (DEPTH, 3 * D_MODEL), jnp.float32)
    norm_g = 1.0 + 0.1 * nrm(ks[6], (DEPTH, D_MODEL), jnp.float32)
    w_in = nrm(ks[7], (DEPTH, D_MODEL, D_IN), jnp.float32) * (D_MODEL ** -0.5)
    b_in = 0.02 * nrm(ks[8], (DEPTH, D_IN), jnp.float32)
    f_off = jnp.linspace(FORGET_BIAS_LO, FORGET_BIAS_HI, B_HEADS, dtype=jnp.float32)
    for name in ('b_f_fwd', 'b_f_bwd'):
        s = _col_start(name)
        b_in = b_in.at[:, s:s + B_HEADS].add(f_off)
    w_spatial = nrm(ks[9], (DEPTH, A_GROUPS, A_CHUNK, A_CHUNK), jnp.float32) * (A_CHUNK ** -0.5)
    b_spatial = 1.0 + 0.1 * nrm(ks[10], (DEPTH, A_GROUPS, A_CHUNK), jnp.float32)
    conv_qk = nrm(ks[11], (DEPTH, CONV_W, 2 * B_WIDTH), jnp.float32) * (CONV_W ** -0.5)
    mlstm_norm = 1.0 + 0.1 * nrm(ks[12], (DEPTH, B_WIDTH), jnp.float32)
    hgrn_lb_logits = 0.1 * nrm(ks[13], (DEPTH, C_KEY_WIDTH), jnp.float32)
    hgrn_norm = 1.0 + 0.1 * nrm(ks[14], (DEPTH, C_WIDTH), jnp.float32)
    w_out = nrm(ks[15], (DEPTH, D_MIX, D_MODEL), jnp.float32) * (D_MIX ** -0.5)
    final_norm = 1.0 + 0.1 * nrm(ks[16], (D_MODEL,), jnp.float32)
    return {'x': x, 'c': c, 'ctx': ctx, 'c_ctx': c_ctx, 'w_ada': w_ada, 'b_ada': b_ada,
            'norm_g': norm_g, 'w_in': w_in, 'b_in': b_in, 'w_spatial': w_spatial,
            'b_spatial': b_spatial, 'conv_qk': conv_qk, 'mlstm_norm': mlstm_norm,
            'hgrn_lb_logits': hgrn_lb_logits, 'hgrn_norm': hgrn_norm, 'w_out': w_out,
            'final_norm': final_norm}


def reference(x, c, ctx, c_ctx, w_ada, b_ada, norm_g, w_in, b_in, w_spatial, b_spatial,
              conv_qk, mlstm_norm, hgrn_lb_logits, hgrn_norm, w_out, final_norm):
    rows = x.shape[1] // GRID_W
    p_lb = jax.nn.softmax(hgrn_lb_logits.astype(jnp.float32), axis=0)
    lower_bounds = jnp.cumsum(p_lb, axis=0) - p_lb[0]
    s_lat = jax.nn.silu(c)
    s_ctx = jax.nn.silu(c_ctx)
    h_lat, h_ctx = x, ctx
    for l in range(DEPTH):
        last = l == DEPTH - 1
        mod_l = (s_lat @ w_ada[l] + b_ada[l])[:, None, :]
        mod_c = s_ctx @ w_ada[l] + b_ada[l]
        sh_l, sc_l, g_l = jnp.split(mod_l, 3, axis=-1)
        sh_c, sc_c, g_c = jnp.split(mod_c, 3, axis=-1)
        n_lat = _rmsnorm(h_lat, norm_g[l]) * (1 + sc_l) + sh_l
        n_ctx = _rmsnorm(h_ctx, norm_g[l]) * (1 + sc_c) + sh_c
        y_ctx, y_lat = _mixer(n_ctx, n_lat, rows, w_in[l], b_in[l], w_spatial[l], b_spatial[l],
                              conv_qk[l], mlstm_norm[l], lower_bounds[l], hgrn_norm[l], w_out[l], last)
        h_lat = h_lat + g_l * y_lat
        if not last:
            h_ctx = h_ctx + g_c * y_ctx
    return _rmsnorm(h_lat, final_norm)
```

```cpp
#include <hip/hip_runtime.h>
#include <hip/hip_cooperative_groups.h>
#include <cstdio>
namespace cg = cooperative_groups;

#define DI __device__ __forceinline__
#define LAS __attribute__((address_space(3)))
typedef unsigned short bf16_t;
typedef unsigned char u8;
typedef short bf16x8 __attribute__((ext_vector_type(8)));
typedef float f32x4 __attribute__((ext_vector_type(4)));
typedef unsigned u32x4 __attribute__((ext_vector_type(4)));
typedef unsigned u32x2 __attribute__((ext_vector_type(2)));

constexpr int DM = 2048, NB = 8, SEQ = 4096, CTXL = 256, DEPTH = 4;
constexpr int MLAT = NB * SEQ, MCTX = NB * CTXL, MTOT = MLAT + MCTX;
constexpr int DIN = 9232, PW = 9216, NGEMM = 9472;
constexpr float EPS = 1e-6f;
constexpr int PC_AU = 0, PC_AV = 512, PC_AZ = 1024, PC_BQ = 1536, PC_BK = 2560, PC_BV = 3584, PC_BO = 4608, PC_BZ = 5632,
              PC_CQ = 6656, PC_CFF = 7168, PC_CFB = 7680, PC_CI = 8192, PC_CG = 8704;
constexpr size_t WS_P = 0;
constexpr size_t WS_N = WS_P + (size_t)MTOT * PW * 2;
constexpr size_t WS_HCTX = WS_N + (size_t)MTOT * DM * 2;
constexpr size_t WS_WIN = WS_HCTX + (size_t)MCTX * DM * 4;
constexpr size_t WS_WOUT = WS_WIN + (size_t)NGEMM * DM * 2;
constexpr size_t WS_IM = WS_WOUT + (size_t)DM * DM * 2;
constexpr size_t WS_IH = WS_IM + (size_t)2 * MTOT * 1024 * 2;
constexpr size_t WS_GATES = WS_IH + (size_t)2 * MTOT * 512 * 2;
constexpr size_t WS_MOD = WS_GATES + (size_t)MTOT * 16 * 4;
constexpr size_t WS_LB = WS_MOD + (size_t)DEPTH * 9 * 6144 * 4;
constexpr size_t WS_MT = WS_LB + (size_t)DEPTH * 512 * 4;
constexpr size_t WS_DEN = WS_MT + (size_t)2 * MTOT * 4 * 4;
constexpr size_t WS_BAR = WS_DEN + (size_t)2 * MTOT * 4 * 4;
constexpr size_t WS_HALO = WS_BAR + 8192;
constexpr size_t WS_OI = WS_HALO + (size_t)272 * 2 * 2048 * 2;
constexpr size_t WS_QB = WS_OI + (size_t)MTOT * 512 * 2;
constexpr size_t WS_DEC = WS_QB + (size_t)MTOT * 512 * 2;
constexpr size_t WS_END = WS_DEC + (size_t)8 * 4 * 68 * 2 * 128 * 4;
constexpr int LDS_BYTES = 147456;

#ifndef DBG_SKIP_P3
#define DBG_SKIP_P3 0
#endif
#ifndef DBG_SKIP_P4
#define DBG_SKIP_P4 0
#endif
#ifndef DBG_NO_M
#define DBG_NO_M 0
#endif
#ifndef DBG_NO_H
#define DBG_NO_H 0
#endif
#ifndef DBG_NO_A
#define DBG_NO_A 0
#endif
#ifndef P2_WGM
#define P2_WGM 4
#endif
struct Params { const float* in[17]; float* out; u8* ws; };

typedef __bf16 bf16x2_t __attribute__((ext_vector_type(2)));
typedef float f32x2_t __attribute__((ext_vector_type(2)));
DI unsigned cvt_pk_bf16(float lo, float hi) { f32x2_t v = {lo, hi}; bf16x2_t b = __builtin_convertvector(v, bf16x2_t); return __builtin_bit_cast(unsigned, b); }
DI float bf_lo(unsigned u) { return __uint_as_float(u << 16); }
DI float bf_hi(unsigned u) { return __uint_as_float(u & 0xffff0000u); }
DI float rcpf_(float x) { return __builtin_amdgcn_rcpf(x); }
DI float sigmoidf_(float x) { return rcpf_(1.0f + __expf(-x)); }
DI float siluf_(float x) { return x * rcpf_(1.0f + __expf(-x)); }
DI float logsigf_(float x) { return fminf(x, 0.f) - __logf(1.0f + __expf(-fabsf(x))); }
DI void unpack8(const u32x4 r, float (&x)[8]) {
    x[0] = bf_lo(r.x); x[1] = bf_hi(r.x); x[2] = bf_lo(r.y); x[3] = bf_hi(r.y); x[4] = bf_lo(r.z); x[5] = bf_hi(r.z); x[6] = bf_lo(r.w); x[7] = bf_hi(r.w);
}
DI unsigned half_sel(unsigned u, int hi) { return hi ? (u >> 16) : (u & 0xffffu); }

template <int NT, int KS>
DI void mma_rows(const LAS u8* A, int lda, int m0, const LAS u8* Bm, int ldb, int n0, f32x4 (&acc)[NT], int fr, int fq) {
    const LAS u8* ap = A + (m0 + fr) * lda + fq * 16;
    const LAS u8* bp = Bm + (n0 + fr) * ldb + fq * 16;
#pragma unroll
    for (int ks = 0; ks < KS; ++ks) {
        const bf16x8 a = *(const LAS bf16x8*)(ap + ks * 64);
#pragma unroll
        for (int nt = 0; nt < NT; ++nt) {
            const bf16x8 b = *(const LAS bf16x8*)(bp + nt * 16 * ldb + ks * 64);
            acc[nt] = __builtin_amdgcn_mfma_f32_16x16x32_bf16(b, a, acc[nt], 0, 0, 0);
        }
    }
}

typedef short s16x4 __attribute__((ext_vector_type(4)));
DI bf16x8 ldfrag_tr(const LAS u8* T, int ld, int k0, int c0, int lane) {
    const int g = lane >> 4, q = (lane >> 2) & 3, p = lane & 3;
    const LAS u8* a = T + (k0 + 8 * g + q) * ld + (c0 + 4 * p) * 2;
    const s16x4 lo = __builtin_amdgcn_ds_read_tr16_b64_v4i16((LAS s16x4*)a);
    const s16x4 hi = __builtin_amdgcn_ds_read_tr16_b64_v4i16((LAS s16x4*)(a + 4 * ld));
    return __builtin_shufflevector(lo, hi, 0, 1, 2, 3, 4, 5, 6, 7);
}
template <int NT, int KS, bool TA, bool TB>
DI void mma_gen(const LAS u8* A, int lda, int m0, const LAS u8* Bm, int ldb, int n0, f32x4 (&acc)[NT], int lane) {
    const int fr = lane & 15, fq = lane >> 4;
#pragma unroll
    for (int ks = 0; ks < KS; ++ks) {
        bf16x8 a;
        if (TA) a = ldfrag_tr(A, lda, ks * 32, m0, lane); else a = *(const LAS bf16x8*)(A + (m0 + fr) * lda + fq * 16 + ks * 64);
#pragma unroll
        for (int nt = 0; nt < NT; ++nt) {
            bf16x8 b;
            if (TB) b = ldfrag_tr(Bm, ldb, ks * 32, n0 + nt * 16, lane); else b = *(const LAS bf16x8*)(Bm + (n0 + nt * 16 + fr) * ldb + fq * 16 + ks * 64);
            acc[nt] = __builtin_amdgcn_mfma_f32_16x16x32_bf16(b, a, acc[nt], 0, 0, 0);
        }
    }
}

template <int MT, int NT, int KS, bool TA, bool TB>
DI void mma_tile(const LAS u8* A, int lda, int m0, const LAS u8* Bm, int ldb, int n0, f32x4 (&acc)[MT][NT], int lane) {
    const int fr = lane & 15, fq = lane >> 4;
#pragma unroll 1
    for (int ks = 0; ks < KS; ++ks) {
        bf16x8 a[MT], b[NT];
#pragma unroll
        for (int mt = 0; mt < MT; ++mt) { if (TA) a[mt] = ldfrag_tr(A, lda, ks * 32, m0 + mt * 16, lane); else a[mt] = *(const LAS bf16x8*)(A + (m0 + mt * 16 + fr) * lda + fq * 16 + ks * 64); }
#pragma unroll
        for (int nt = 0; nt < NT; ++nt) { if (TB) b[nt] = ldfrag_tr(Bm, ldb, ks * 32, n0 + nt * 16, lane); else b[nt] = *(const LAS bf16x8*)(Bm + (n0 + nt * 16 + fr) * ldb + fq * 16 + ks * 64); }
#pragma unroll
        for (int mt = 0; mt < MT; ++mt)
#pragma unroll
            for (int nt = 0; nt < NT; ++nt) acc[mt][nt] = __builtin_amdgcn_mfma_f32_16x16x32_bf16(b[nt], a[mt], acc[mt][nt], 0, 0, 0);
    }
}

namespace pg8 {
constexpr int BM = 256, BK = 64, HALF = 128, HTB = HALF * BK * 2, STAGE_BYTES = 8 * HTB, NXCD = 8, WGM = 8;
DI int lds_byte(int r, int c) { const int st = (r >> 4) * 2 + (c >> 5), rr = r & 15, cc = c & 31, ob = rr * 64 + cc * 2; return st * 1024 + (ob ^ (((ob >> 9) & 1) << 5)); }
DI void stage_rc(int b, int& R, int& C) { const int st = b / 1024, sb = b % 1024, swz = sb ^ (((sb >> 9) & 1) << 5); R = (st >> 1) * 16 + swz / 64; C = (st & 1) * 32 + (swz % 64) / 2; }
DI int perm32(int rho) { const int n = rho >> 4, i = rho & 15; return 8 * (i >> 2) + 4 * n + (i & 3); }
struct Unit { int pm, pn; };
struct Gemm { const bf16_t* A; const bf16_t* Bt; int M, N, K; };
struct StaticOrder {
    int nM, nN, nwg, G, c, wgm;
    DI void init(int M, int N, int G_, int c_, int wgm_ = WGM) { nM = M / BM; nN = N / BM; nwg = nM * nN; G = G_; c = c_; wgm = wgm_; }
    DI bool next(int i, Unit& u) const {
        const long L = (long)i * G + c; if (L >= nwg) return false;
        int wgid = (int)L; { const int q = nwg / NXCD, r = nwg % NXCD, xcd = wgid % NXCD, off = wgid / NXCD; wgid = (xcd < r ? xcd * (q + 1) : r * (q + 1) + (xcd - r) * q) + off; }
        const int nig = wgm * nN, gid = wgid / nig, fm = gid * wgm, gsz = (nM - fm) < wgm ? (nM - fm) : wgm;
        u.pm = fm + ((wgid % nig) % gsz); u.pn = (wgid % nig) / gsz; return true;
    }
};

template <class Epi>
DI void gemm_phase(LAS u8* lds, const Gemm g, const StaticOrder& S, const Epi& E, const int tid) {
    const int wid = __builtin_amdgcn_readfirstlane(tid >> 6), lane = tid & 63, wr = wid >> 2, wc = wid & 3, fr = lane & 15, fq = lane >> 4;
    const int K = g.K, nt = K / BK;
    unsigned voffA[2], voffB[2];
#pragma unroll
    for (int i = 0; i < 2; ++i) { int R, C; stage_rc(tid * 16 + i * 8192, R, C); const int Rb = Epi::PERM ? (64 * (R >> 5) + perm32(R & 31)) : R;
        voffA[i] = (unsigned)(R * K + C) * 2u; voffB[i] = (unsigned)(Rb * K + C) * 2u; }
    const size_t kstep = (size_t)(BK * 2);
    const size_t hstep = (size_t)HALF * K * 2;
    const size_t tstep = 2 * hstep;
    const size_t hstepB = Epi::PERM ? (size_t)32 * K * 2 : hstep;
    const unsigned ldsw = (unsigned)wid * 1024u;
    const int aoff = lds_byte(wr * 64 + fr, fq * 8), boff = lds_byte(wc * 32 + fr, fq * 8);
#define PG8_SA(b, h) (((b) * 2 + (h)) * HTB)
#define PG8_SB(b, h) ((4 + (b) * 2 + (h)) * HTB)
#define PG8_STAGE(bufoff, gbase, voff) do { _Pragma("unroll") for (int _i = 0; _i < 2; ++_i) \
        __builtin_amdgcn_global_load_lds((const unsigned*)((const char*)(gbase) + (voff)[_i]), (LAS unsigned*)(lds + (bufoff) + ldsw + _i * 8192), 16, 0, 0); } while (0)
#define PG8_LDA(dst, b, h) do { _Pragma("unroll") for (int m = 0; m < 4; ++m) _Pragma("unroll") for (int k = 0; k < 2; ++k) dst[m][k] = *(const LAS bf16x8*)(lds + PG8_SA(b, h) + aoff + m * 2048 + k * 1024); } while (0)
#define PG8_LDB(dst, b, h) do { _Pragma("unroll") for (int n = 0; n < 2; ++n) _Pragma("unroll") for (int k = 0; k < 2; ++k) dst[n][k] = *(const LAS bf16x8*)(lds + PG8_SB(b, h) + boff + n * 2048 + k * 1024); } while (0)
#define PG8_MMA(ai, bj, At, Bt) do { __builtin_amdgcn_s_setprio(1); _Pragma("unroll") for (int m = 0; m < 4; ++m) _Pragma("unroll") for (int n = 0; n < 2; ++n) _Pragma("unroll") for (int k = 0; k < 2; ++k) \
        acc[ai][bj][m][n] = __builtin_amdgcn_mfma_f32_16x16x32_bf16(Bt[n][k], At[m][k], acc[ai][bj][m][n], 0, 0, 0); __builtin_amdgcn_s_setprio(0); } while (0)
#define PG8_WAIT_V(n) asm volatile("s_waitcnt vmcnt(" #n ")" ::: "memory")
#define PG8_WAIT_L(n) asm volatile("s_waitcnt lgkmcnt(" #n ")" ::: "memory")
#define PG8_BAR __builtin_amdgcn_s_barrier()
#define PG8_SCHED __builtin_amdgcn_sched_barrier(0)
    Unit cur, nxt; int ui = 0;
    if (!S.next(0, cur)) return;
    f32x4 acc[2][2][4][2];
#pragma unroll
    for (int a = 0; a < 2; ++a)
#pragma unroll
        for (int b = 0; b < 2; ++b)
#pragma unroll
            for (int m = 0; m < 4; ++m)
#pragma unroll
                for (int n = 0; n < 2; ++n) acc[a][b][m][n] = (f32x4){0.f, 0.f, 0.f, 0.f};
    bf16x8 At[4][2], B0[2][2], B1[2][2];
    const char* cA = (const char*)g.A + (size_t)cur.pm * tstep; const char* cB = (const char*)g.Bt + (size_t)cur.pn * tstep;
    PG8_STAGE(PG8_SB(0, 0), cB, voffB); PG8_STAGE(PG8_SA(0, 0), cA, voffA); PG8_STAGE(PG8_SB(0, 1), cB + hstepB, voffB); PG8_STAGE(PG8_SA(0, 1), cA + hstep, voffA);
    if (wr == 1) PG8_BAR;
    PG8_WAIT_V(4); PG8_BAR;
    PG8_STAGE(PG8_SB(1, 0), cB + kstep, voffB); PG8_STAGE(PG8_SA(1, 0), cA + kstep, voffA); PG8_STAGE(PG8_SB(1, 1), cB + hstepB + kstep, voffB);
    PG8_WAIT_V(6); PG8_BAR;
    for (;;) {
        const bool has_next = S.next(ui + 1, nxt);
        const char* nA = has_next ? (const char*)g.A + (size_t)nxt.pm * tstep : cA; const char* nB = has_next ? (const char*)g.Bt + (size_t)nxt.pn * tstep : cB;
        for (int t = 0; t < nt; t += 2) {
            const bool last = (t == nt - 2);
            const char* a1 = cA + (size_t)(t + 1) * kstep;
            const char* a2 = last ? nA : cA + (size_t)(t + 2) * kstep; const char* b2 = last ? nB : cB + (size_t)(t + 2) * kstep;
            const char* a3 = a2 + kstep; const char* b3 = b2 + kstep;
            PG8_LDB(B0, 0, 0); PG8_SCHED; PG8_LDA(At, 0, 0); PG8_STAGE(PG8_SA(1, 1), a1 + hstep, voffA);
            PG8_WAIT_L(8); PG8_BAR; PG8_WAIT_L(0); PG8_MMA(0, 0, At, B0); PG8_BAR; PG8_SCHED;
            PG8_LDB(B1, 0, 1); PG8_STAGE(PG8_SB(0, 0), b2, voffB);
            PG8_BAR; PG8_WAIT_L(0); PG8_MMA(0, 1, At, B1); PG8_BAR;
            PG8_LDA(At, 0, 1); PG8_STAGE(PG8_SA(0, 0), a2, voffA);
            PG8_BAR; PG8_WAIT_L(0); PG8_MMA(1, 0, At, B0); PG8_BAR; PG8_SCHED;
            PG8_STAGE(PG8_SB(0, 1), b2 + hstepB, voffB);
            PG8_WAIT_V(6); PG8_BAR; PG8_MMA(1, 1, At, B1); PG8_BAR;
            PG8_LDB(B0, 1, 0); PG8_SCHED; PG8_LDA(At, 1, 0); PG8_STAGE(PG8_SA(0, 1), a2 + hstep, voffA);
            PG8_WAIT_L(8); PG8_BAR; PG8_WAIT_L(0); PG8_MMA(0, 0, At, B0); PG8_BAR; PG8_SCHED;
            PG8_LDB(B1, 1, 1); PG8_STAGE(PG8_SB(1, 0), b3, voffB);
            PG8_BAR; PG8_WAIT_L(0); PG8_MMA(0, 1, At, B1); PG8_BAR;
            PG8_LDA(At, 1, 1); PG8_STAGE(PG8_SA(1, 0), a3, voffA);
            PG8_BAR; PG8_WAIT_L(0); PG8_MMA(1, 0, At, B0); PG8_BAR; PG8_SCHED;
            PG8_STAGE(PG8_SB(1, 1), b3 + hstepB, voffB);
            PG8_WAIT_V(6); PG8_BAR; PG8_MMA(1, 1, At, B1); PG8_BAR;
        }
        E(acc, cur, wr, wc, fr, fq);
        if (!has_next) break;
#pragma unroll
        for (int a = 0; a < 2; ++a)
#pragma unroll
            for (int b = 0; b < 2; ++b)
#pragma unroll
                for (int m = 0; m < 4; ++m)
#pragma unroll
                    for (int n = 0; n < 2; ++n) acc[a][b][m][n] = (f32x4){0.f, 0.f, 0.f, 0.f};
        cur = nxt; cA = nA; cB = nB; ++ui;
    }
    PG8_WAIT_V(0);
    if (wr == 0) PG8_BAR;
    PG8_BAR;
#undef PG8_SA
#undef PG8_SB
#undef PG8_STAGE
#undef PG8_LDA
#undef PG8_LDB
#undef PG8_MMA
#undef PG8_WAIT_V
#undef PG8_WAIT_L
#undef PG8_BAR
#undef PG8_SCHED
}

struct EpiP {
    static constexpr bool PERM = true;
    bf16_t* Pb; float* gates; const float* bias; bf16_t* halo;
    DI void operator()(const f32x4 (&acc)[2][2][4][2], const Unit& u, int wr, int wc, int fr, int fq) const {
        const int row0 = u.pm * BM + wr * 64 + fr;
        if (u.pn < 36) {
            const int col0 = u.pn * BM + wc * 64 + 8 * fq;
            f32x4 bv[2][2];
#pragma unroll
            for (int bj = 0; bj < 2; ++bj) { const int c = col0 + bj * 32; const int oc = c < 6656 ? c : c + 16;
                bv[bj][0] = *(const f32x4*)(bias + oc); bv[bj][1] = *(const f32x4*)(bias + oc + 4); }
#pragma unroll
            for (int ai = 0; ai < 2; ++ai)
#pragma unroll
                for (int m = 0; m < 4; ++m) { bf16_t* rowp = Pb + (size_t)(row0 + ai * HALF + m * 16) * PW + col0;
#pragma unroll
                    for (int bj = 0; bj < 2; ++bj) { const f32x4 v0 = acc[ai][bj][m][0] + bv[bj][0], v1 = acc[ai][bj][m][1] + bv[bj][1];
                        u32x4 w; w.x = cvt_pk_bf16(v0[0], v0[1]); w.y = cvt_pk_bf16(v0[2], v0[3]); w.z = cvt_pk_bf16(v1[0], v1[1]); w.w = cvt_pk_bf16(v1[2], v1[3]);
                        *(u32x4*)(rowp + bj * 32) = w;
                        if (u.pn >= 6 && u.pn < 14) {
                            const int rr = wr * 64 + m * 16 + fr;
                            if (rr == 0 || rr == 127) *(u32x4*)(halo + ((size_t)((row0 + ai * HALF + m * 16) >> 7) * 2 + (rr ? 1 : 0)) * 2048 + (col0 - 1536) + bj * 32) = w; } } }
        } else if (wc == 0 && fq < 2) {
            const f32x4 b0 = *(const f32x4*)(bias + 6656 + 8 * fq), b1 = *(const f32x4*)(bias + 6656 + 8 * fq + 4);
#pragma unroll
            for (int ai = 0; ai < 2; ++ai)
#pragma unroll
                for (int m = 0; m < 4; ++m) { float* gp = gates + (size_t)(row0 + ai * HALF + m * 16) * 16 + 8 * fq;
                    *(f32x4*)(gp) = acc[ai][0][m][0] + b0; *(f32x4*)(gp + 4) = acc[ai][0][m][1] + b1; }
        }
    }
};
struct EpiH {
    static constexpr bool PERM = true;
    const float* x_in; bf16_t* hb; bf16_t* hb_last; const float* hc_in; float* hc_out; const float* mod; int first, lastl;
    DI void operator()(const f32x4 (&acc)[2][2][4][2], const Unit& u, int wr, int wc, int fr, int fq) const {
        const int row0 = u.pm * BM + wr * 64 + fr, col0 = u.pn * BM + wc * 64 + 8 * fq;
        const bool lat = (u.pm * BM) < MLAT;
        const int b = lat ? ((u.pm * BM) >> 12) : 8;
        const float* gg = mod + b * 6144 + 4096 + col0;
        f32x4 gv[2][2];
#pragma unroll
        for (int bj = 0; bj < 2; ++bj)
#pragma unroll
            for (int n = 0; n < 2; ++n) gv[bj][n] = *(const f32x4*)(gg + bj * 32 + n * 4);
        if (lat && !first) {
#pragma unroll
            for (int ai = 0; ai < 2; ++ai) {
                u32x4 hv[4][2];
#pragma unroll
                for (int m = 0; m < 4; ++m) { const bf16_t* src = hb + (size_t)(row0 + ai * HALF + m * 16) * DM + col0;
#pragma unroll
                    for (int bj = 0; bj < 2; ++bj) hv[m][bj] = *(const u32x4*)(src + bj * 32); }
#pragma unroll
                for (int m = 0; m < 4; ++m) { const size_t off = (size_t)(row0 + ai * HALF + m * 16) * DM + col0;
#pragma unroll
                    for (int bj = 0; bj < 2; ++bj) { float h8[8]; unpack8(hv[m][bj], h8);
                        const f32x4 o0 = (f32x4){h8[0], h8[1], h8[2], h8[3]} + gv[bj][0] * acc[ai][bj][m][0], o1 = (f32x4){h8[4], h8[5], h8[6], h8[7]} + gv[bj][1] * acc[ai][bj][m][1];
                        u32x4 w; w.x = cvt_pk_bf16(o0[0], o0[1]); w.y = cvt_pk_bf16(o0[2], o0[3]); w.z = cvt_pk_bf16(o1[0], o1[1]); w.w = cvt_pk_bf16(o1[2], o1[3]);
                        *(u32x4*)((lastl ? hb_last : hb) + off + bj * 32) = w; } }
            }
        } else {
#pragma unroll
            for (int ai = 0; ai < 2; ++ai)
#pragma unroll
                for (int m = 0; m < 4; m += 2) {
                    f32x4 hv[2][2][2];
#pragma unroll
                    for (int m2 = 0; m2 < 2; ++m2) { const int row = row0 + ai * HALF + (m + m2) * 16;
                        const float* src = (lat ? x_in + (size_t)row * DM : hc_in + (size_t)(row - MLAT) * DM) + col0;
#pragma unroll
                        for (int bj = 0; bj < 2; ++bj)
#pragma unroll
                            for (int n = 0; n < 2; ++n) hv[m2][bj][n] = *(const f32x4*)(src + bj * 32 + n * 4); }
#pragma unroll
                    for (int m2 = 0; m2 < 2; ++m2) { const int row = row0 + ai * HALF + (m + m2) * 16;
#pragma unroll
                        for (int bj = 0; bj < 2; ++bj) { const f32x4 o0 = hv[m2][bj][0] + gv[bj][0] * acc[ai][bj][m + m2][0], o1 = hv[m2][bj][1] + gv[bj][1] * acc[ai][bj][m + m2][1];
                            if (!lat) { float* dst = hc_out + (size_t)(row - MLAT) * DM + col0 + bj * 32; *(f32x4*)(dst) = o0; *(f32x4*)(dst + 4) = o1; }
                            else { u32x4 w; w.x = cvt_pk_bf16(o0[0], o0[1]); w.y = cvt_pk_bf16(o0[2], o0[3]); w.z = cvt_pk_bf16(o1[0], o1[1]); w.w = cvt_pk_bf16(o1[2], o1[3]); *(u32x4*)((lastl ? hb_last : hb) + (size_t)row * DM + col0 + bj * 32) = w; } } }
                }
        }
    }
};
}

DI void phase0(const Params& P, LAS u8* lds, int tid) {
    LAS float* s = (LAS float*)lds;
    LAS float* red = (LAS float*)(lds + 73728);
    const float* c = P.in[1]; const float* cctx = P.in[3]; const float* w_ada = P.in[4]; const float* b_ada = P.in[5];
    float* mod = (float*)(P.ws + WS_MOD);
    for (int i = tid; i < 9 * 2048; i += 512) { const float v = i < 8 * 2048 ? c[i] : cctx[i - 8 * 2048]; s[i] = siluf_(v); }
    if (blockIdx.x == 0) {
        const float* lg = P.in[13]; float* lb = (float*)(P.ws + WS_LB);
        const float a0 = lg[tid], a1 = lg[512 + tid], a2 = lg[1024 + tid], a3 = lg[1536 + tid];
        const float mx = fmaxf(fmaxf(a0, a1), fmaxf(a2, a3));
        const float e0 = expf(a0 - mx), e1 = expf(a1 - mx), e2 = expf(a2 - mx), e3 = expf(a3 - mx);
        const float inv = 1.0f / (e0 + e1 + e2 + e3);
        const float p0 = e0 * inv, p1 = e1 * inv, p2 = e2 * inv, p3 = e3 * inv;
        lb[tid] = p0 - p0; lb[512 + tid] = (p0 + p1) - p0; lb[1024 + tid] = (p0 + p1 + p2) - p0; lb[1536 + tid] = (p0 + p1 + p2 + p3) - p0;
    }
    __syncthreads();
    const int w = tid >> 6, lane = tid & 63, cgp = lane & 15, kq = lane >> 4;
    for (int task = blockIdx.x; task < 384; task += gridDim.x) {
        const int l = task / 96, cb = task % 96;
        const float* W = w_ada + (size_t)l * 2048 * 6144 + cb * 64 + cgp * 4;
        f32x4 acc[9];
#pragma unroll
        for (int b = 0; b < 9; ++b) acc[b] = (f32x4){0.f, 0.f, 0.f, 0.f};
#pragma unroll 4
        for (int kk = 0; kk < 64; ++kk) {
            const int k = w * 256 + kk * 4 + kq;
            const f32x4 wv = __builtin_nontemporal_load((const f32x4*)(W + (size_t)k * 6144));
#pragma unroll
            for (int b = 0; b < 9; ++b) acc[b] += s[b * 2048 + k] * wv;
        }
#pragma unroll
        for (int b = 0; b < 9; ++b)
#pragma unroll
            for (int j = 0; j < 4; ++j) { float v = acc[b][j]; v += __shfl_xor(v, 16); v += __shfl_xor(v, 32); if (kq == 0) red[(w * 9 + b) * 64 + cgp * 4 + j] = v; }
        __syncthreads();
        for (int i = tid; i < 576; i += 512) { const int b = i >> 6, cc = i & 63; float v = b_ada[l * 6144 + cb * 64 + cc];
#pragma unroll
            for (int ww = 0; ww < 8; ++ww) v += red[(ww * 9 + b) * 64 + cc];
            mod[(size_t)(l * 9 + b) * 6144 + cb * 64 + cc] = v; }
        __syncthreads();
    }
}

DI void conv_tile(const float* src, int ld, int nvalid, bf16_t* dst, LAS float* tile, int tid) {
    const int kr = tid >> 4, ng = tid & 15;
#pragma unroll
    for (int h = 0; h < 2; ++h) { const int k = kr + 32 * h;
        f32x4 v = (f32x4){0.f, 0.f, 0.f, 0.f};
        if (ng * 4 < nvalid) v = __builtin_nontemporal_load((const f32x4*)(src + (size_t)k * ld + ng * 4));
        tile[k * 65 + ng * 4 + 0] = v[0]; tile[k * 65 + ng * 4 + 1] = v[1]; tile[k * 65 + ng * 4 + 2] = v[2]; tile[k * 65 + ng * 4 + 3] = v[3]; }
    __syncthreads();
    const int nr = tid >> 3, kg = tid & 7;
    float x[8];
#pragma unroll
    for (int j = 0; j < 8; ++j) x[j] = tile[(kg * 8 + j) * 65 + nr];
    u32x4 w; w.x = cvt_pk_bf16(x[0], x[1]); w.y = cvt_pk_bf16(x[2], x[3]); w.z = cvt_pk_bf16(x[4], x[5]); w.w = cvt_pk_bf16(x[6], x[7]);
    *(u32x4*)(dst + (size_t)nr * DM + kg * 8) = w;
    __syncthreads();
}

DI void phase1(const Params& P, int l, LAS u8* lds, int tid) {
    const float* hl = P.in[0]; const bf16_t* hb = (const bf16_t*)P.out; const float* hc = l == 0 ? P.in[2] : (const float*)(P.ws + WS_HCTX);
    const float* mod = (const float*)(P.ws + WS_MOD) + (size_t)l * 9 * 6144;
    const float* ng = P.in[6] + l * DM;
    bf16_t* N = (bf16_t*)(P.ws + WS_N);
    const int w = tid >> 6, lane = tid & 63;
    for (int grp = blockIdx.x; grp < MTOT / 32; grp += gridDim.x) {
        const int r0 = grp * 32 + w * 4;
        const int b = r0 < MLAT ? (r0 >> 12) : 8;
        const float* mb = mod + b * 6144;
        f32x4 gm[8], sh[8];
#pragma unroll
        for (int i = 0; i < 8; ++i) { const int c = (i * 64 + lane) * 4;
            const f32x4 g4 = *(const f32x4*)(ng + c), sc = *(const f32x4*)(mb + 2048 + c);
            gm[i] = g4 * (1.0f + sc); sh[i] = *(const f32x4*)(mb + c); }
#pragma unroll 1
        for (int r = 0; r < 4; ++r) { const int row = r0 + r;
            f32x4 x[8]; float ss = 0.f;
            if (row < MLAT && l > 0) {
                const bf16_t* srcb = hb + (size_t)row * DM;
#pragma unroll
                for (int i = 0; i < 8; ++i) { const u32x2 r2 = __builtin_nontemporal_load((const u32x2*)(srcb + (i * 64 + lane) * 4)); x[i] = (f32x4){bf_lo(r2.x), bf_hi(r2.x), bf_lo(r2.y), bf_hi(r2.y)}; }
            } else {
                const float* src = row < MLAT ? hl + (size_t)row * DM : hc + (size_t)(row - MLAT) * DM;
#pragma unroll
                for (int i = 0; i < 8; ++i) x[i] = __builtin_nontemporal_load((const f32x4*)(src + (i * 64 + lane) * 4));
            }
#pragma unroll
            for (int i = 0; i < 8; ++i) ss += x[i][0] * x[i][0] + x[i][1] * x[i][1] + x[i][2] * x[i][2] + x[i][3] * x[i][3];
#pragma unroll
            for (int o = 32; o >= 1; o >>= 1) ss += __shfl_xor(ss, o);
            const float rstd = rsqrtf(ss * (1.0f / DM) + EPS);
            bf16_t* dst = N + (size_t)row * DM;
#pragma unroll
            for (int i = 0; i < 8; ++i) { const f32x4 y = x[i] * rstd * gm[i] + sh[i];
                u32x2 pk; pk.x = cvt_pk_bf16(y[0], y[1]); pk.y = cvt_pk_bf16(y[2], y[3]);
                *(u32x2*)(dst + (i * 64 + lane) * 4) = pk; } }
    }
    LAS float* tile = (LAS float*)lds;
    const float* win = P.in[7] + (size_t)l * DM * DIN; const float* wout = P.in[15] + (size_t)l * DM * DM;
    bf16_t* WinT = (bf16_t*)(P.ws + WS_WIN); bf16_t* WoutT = (bf16_t*)(P.ws + WS_WOUT);
    constexpr int NT_IN = (NGEMM / 64) * 32, NT_OUT = 32 * 32;
    for (int t = blockIdx.x; t < NT_IN + NT_OUT; t += gridDim.x) {
        if (t < NT_IN) { const int nt = t >> 5, kt = t & 31; const int np = nt * 64;
            int nsrc, nvalid;
            if (np < 6656) { nsrc = np; nvalid = 64; } else if (np < 9216) { nsrc = np + 16; nvalid = 64; } else if (np == 9216) { nsrc = 6656; nvalid = 16; } else { nsrc = 0; nvalid = 0; }
            conv_tile(win + (size_t)(kt * 64) * DIN + nsrc, DIN, nvalid, WinT + (size_t)np * DM + kt * 64, tile, tid);
        } else { const int tt = t - NT_IN; const int nt = tt >> 5, kt = tt & 31;
            conv_tile(wout + (size_t)(kt * 64) * DM + nt * 64, DM, 64, WoutT + (size_t)(nt * 64) * DM + kt * 64, tile, tid); }
    }
}

DI void task_chunkmlp(const Params& P, int l, int cidx, int g, LAS u8* lds, int tid) {
    LAS u8* wsA = lds; LAS u8* vnT = lds + 34816;
    const bf16_t* Pb = (const bf16_t*)(P.ws + WS_P); bf16_t* mix = (bf16_t*)(P.ws + WS_N);
    const int w = tid >> 6, lane = tid & 63, fr = lane & 15, fq = lane >> 4;
    const int R0 = cidx * 128;
    const float* Ws = P.in[9] + (size_t)(l * 4 + g) * 16384;
#pragma unroll
    for (int i = 0; i < 8; ++i) { const int idx = i * 512 + tid, t = idx >> 5, s4 = (idx & 31) * 4;
        const f32x4 v = *(const f32x4*)(Ws + t * 128 + s4);
        u32x2 pk; pk.x = cvt_pk_bf16(v[0], v[1]); pk.y = cvt_pk_bf16(v[2], v[3]);
        *(LAS u32x2*)(wsA + t * 272 + s4 * 2) = pk; }
    {
        const int s = tid >> 2, qd = tid & 3;
        const bf16_t* vp = Pb + (size_t)(R0 + s) * PW + PC_AV + g * 128 + qd * 32;
        float x[32];
#pragma unroll
        for (int i = 0; i < 4; ++i) { const u32x4 r = *(const u32x4*)(vp + i * 8); float t8[8]; unpack8(r, t8);
#pragma unroll
            for (int j = 0; j < 8; ++j) x[i * 8 + j] = t8[j]; }
        float sm = 0.f;
#pragma unroll
        for (int i = 0; i < 32; ++i) sm += x[i];
        sm += __shfl_xor(sm, 1); sm += __shfl_xor(sm, 2);
        const float mu = sm * (1.0f / 128.0f);
        float vq = 0.f;
#pragma unroll
        for (int i = 0; i < 32; ++i) { x[i] -= mu; vq += x[i] * x[i]; }
        vq += __shfl_xor(vq, 1); vq += __shfl_xor(vq, 2);
        const float rs = rsqrtf(vq * (1.0f / 128.0f) + EPS);
#pragma unroll
        for (int i = 0; i < 32; i += 2) { const unsigned pk = cvt_pk_bf16(x[i] * rs, x[i + 1] * rs);
            *(LAS bf16_t*)(vnT + (qd * 32 + 16 * ((i >> 2) & 1) + 4 * (i >> 3) + (i & 3)) * 272 + s * 2) = (bf16_t)(pk & 0xffffu);
            *(LAS bf16_t*)(vnT + (qd * 32 + 16 * (((i + 1) >> 2) & 1) + 4 * ((i + 1) >> 3) + ((i + 1) & 3)) * 272 + s * 2) = (bf16_t)(pk >> 16); }
    }
    __syncthreads();
    f32x4 acc[8];
#pragma unroll
    for (int i = 0; i < 8; ++i) acc[i] = (f32x4){0.f, 0.f, 0.f, 0.f};
    mma_rows<8, 4>(wsA, 272, 16 * w, vnT, 272, 0, acc, fr, fq);
    const int t = 16 * w + fr; const size_t R = (size_t)(R0 + t);
    const float bs = P.in[10][(l * 4 + g) * 128 + t];
#pragma unroll
    for (int gp = 0; gp < 4; ++gp) { const int c = g * 128 + gp * 32 + 8 * fq;
        const u32x4 ur = *(const u32x4*)(Pb + R * PW + PC_AU + c), zr = *(const u32x4*)(Pb + R * PW + PC_AZ + c);
        float uf[8], zf[8]; unpack8(ur, uf); unpack8(zr, zf);
        float y[8];
#pragma unroll
        for (int j = 0; j < 4; ++j) { y[j] = uf[j] * (acc[2 * gp][j] + bs) * siluf_(zf[j]); y[4 + j] = uf[4 + j] * (acc[2 * gp + 1][j] + bs) * siluf_(zf[4 + j]); }
        u32x4 pk; pk.x = cvt_pk_bf16(y[0], y[1]); pk.y = cvt_pk_bf16(y[2], y[3]); pk.z = cvt_pk_bf16(y[4], y[5]); pk.w = cvt_pk_bf16(y[6], y[7]);
        *(u32x4*)(mix + R * DM + c) = pk; }
    __syncthreads();
}

DI void task_conv(const Params& P, int l, int chunk, int isk, int h, int tid) {
    bf16_t* Pb = (bf16_t*)(P.ws + WS_P); const bf16_t* halo = (const bf16_t*)(P.ws + WS_HALO);
    const int cg = tid & 31, rg = tid >> 5; const int d0 = cg * 8, t0 = rg * 8;
    const int R0 = chunk * 128;
    const bool has_prev = (chunk < 256) ? ((chunk & 31) != 0) : ((chunk & 1) != 0);
    const bool has_next = (chunk < 256) ? ((chunk & 31) != 31) : ((chunk & 1) != 1);
    const float* cw = P.in[11] + (size_t)l * 3 * 2048 + isk * 1024 + h * 256;
    const float scale = isk ? 0.0625f : 1.0f;
    const int hc = isk * 1024 + h * 256 + d0;
    bf16_t* base = Pb + (size_t)(R0 + t0) * PW + PC_BQ + hc;
    u32x4 raw[10];
#pragma unroll
    for (int r = 1; r < 9; ++r) raw[r] = *(const u32x4*)(base + (ptrdiff_t)(r - 1) * PW);
    raw[0] = (u32x4){0u, 0u, 0u, 0u}; raw[9] = raw[0];
    if (t0 > 0) raw[0] = *(const u32x4*)(base - (ptrdiff_t)PW);
    else if (has_prev) raw[0] = *(const u32x4*)(halo + ((size_t)(chunk - 1) * 2 + 1) * 2048 + hc);
    if (t0 < 120) raw[9] = *(const u32x4*)(base + (ptrdiff_t)8 * PW);
    else if (has_next) raw[9] = *(const u32x4*)(halo + ((size_t)(chunk + 1) * 2 + 0) * 2048 + hc);
    float w0[8], w1[8], w2[8];
#pragma unroll
    for (int hh = 0; hh < 2; ++hh) { const f32x4 a = *(const f32x4*)(cw + d0 + 4 * hh), b = *(const f32x4*)(cw + 2048 + d0 + 4 * hh), c = *(const f32x4*)(cw + 4096 + d0 + 4 * hh);
#pragma unroll
        for (int j = 0; j < 4; ++j) { w0[4 * hh + j] = a[j]; w1[4 * hh + j] = b[j]; w2[4 * hh + j] = c[j]; } }
    asm volatile("s_waitcnt vmcnt(0)" ::: "memory");
    __syncthreads();
    float xp[8], xc[8], xn[8];
    unpack8(raw[0], xp); unpack8(raw[1], xc);
#pragma unroll
    for (int r = 0; r < 8; ++r) {
        unpack8(raw[r + 2], xn);
        float y[8];
#pragma unroll
        for (int c = 0; c < 8; ++c) { const float v = w0[c] * xp[c] + w1[c] * xc[c] + w2[c] * xn[c]; y[c] = siluf_(v) * scale; }
        u32x4 o; o.x = cvt_pk_bf16(y[0], y[1]); o.y = cvt_pk_bf16(y[2], y[3]); o.z = cvt_pk_bf16(y[4], y[5]); o.w = cvt_pk_bf16(y[6], y[7]);
        *(u32x4*)(base + (ptrdiff_t)r * PW) = o;
#pragma unroll
        for (int c = 0; c < 8; ++c) { xp[c] = xc[c]; xc[c] = xn[c]; }
    }
}

template <bool TR>
DI void stage_plain(const bf16_t* Pb, int R0, int col0, LAS u8* dst, int tid) {
    const int cg = tid & 31, rg = tid >> 5; const int d0 = cg * 8, t0 = rg * 8;
    const bf16_t* base = Pb + (size_t)(R0 + t0) * PW + col0 + d0;
    u32x4 raw[8];
#pragma unroll
    for (int r = 0; r < 8; ++r) raw[r] = *(const u32x4*)(base + (size_t)r * PW);
    if (!TR) {
#pragma unroll
        for (int r = 0; r < 8; ++r) *(LAS u32x4*)(dst + (t0 + r) * 528 + d0 * 2) = raw[r];
    } else {
#pragma unroll
        for (int c = 0; c < 8; ++c) { u32x4 v; const int cw = c >> 1, hi = c & 1;
            v.x = half_sel(raw[0][cw], hi) | (half_sel(raw[1][cw], hi) << 16); v.y = half_sel(raw[2][cw], hi) | (half_sel(raw[3][cw], hi) << 16);
            v.z = half_sel(raw[4][cw], hi) | (half_sel(raw[5][cw], hi) << 16); v.w = half_sel(raw[6][cw], hi) | (half_sel(raw[7][cw], hi) << 16);
            *(LAS u32x4*)(dst + (d0 + c) * 272 + t0 * 2) = v; }
    }
}

struct GateScan { int t0, t1; float cb0, cb1, gi0, gi1; };
DI GateScan gate_scan(const float* G, int R0, int dir, int h, int lane) {
    GateScan r;
    const int p0 = 2 * lane, p1 = p0 + 1;
    r.t0 = dir ? 127 - p0 : p0; r.t1 = dir ? 127 - p1 : p1;
    const float* g0 = G + (size_t)(R0 + r.t0) * 16 + dir * 8 + h; const float* g1 = G + (size_t)(R0 + r.t1) * 16 + dir * 8 + h;
    r.gi0 = g0[0]; r.gi1 = g1[0];
    const float x0 = logsigf_(g0[4]), x1 = logsigf_(g1[4]);
    float s = x0 + x1;
#pragma unroll
    for (int o = 1; o < 64; o <<= 1) { const float v = __shfl_up(s, o); if (lane >= o) s += v; }
    r.cb1 = s; r.cb0 = s - x1;
    return r;
}

DI void task_m1(const Params& P, int l, int task, LAS u8* lds, const int tid0) {
    const int b = task >> 4, h = (task >> 2) & 3, dir = (task >> 1) & 1, sl = task & 1;
    LAS u8* QN = lds;
    LAS u8* CB = lds + 67584;
    LAS u8* WS16 = lds + 102400;
    LAS u8* NB = lds + 135168;
    LAS float* einter = (LAS float*)(lds + 143616); LAS float* wsv = einter + 128; LAS float* scal = wsv + 128;
    const bf16_t* Pb = (const bf16_t*)(P.ws + WS_P); const float* G = (const float*)(P.ws + WS_GATES);
    bf16_t* IM = (bf16_t*)(P.ws + WS_IM); float* MT = (float*)(P.ws + WS_MT); float* DEN = (float*)(P.ws + WS_DEN);
    f32x4 Cst[4][4]; f32x4 nacc[1][2];
#pragma unroll
    for (int i = 0; i < 4; ++i)
#pragma unroll
        for (int j = 0; j < 4; ++j) Cst[i][j] = (f32x4){0.f, 0.f, 0.f, 0.f};
    nacc[0][0] = (f32x4){0.f, 0.f, 0.f, 0.f}; nacc[0][1] = nacc[0][0];
    float m_prev = 0.f;
    u32x4 rq[8], rk[8], rv[4];
#define M1_R0(n_) (((n_) < 2) ? (MLAT + b * CTXL + (dir ? 1 - (n_) : (n_)) * 128) : (b * SEQ + (dir ? 31 - ((n_) - 2) : (n_) - 2) * 128))
    {
        const int R0 = M1_R0(0);
        const bf16_t* base = Pb + (size_t)(R0 + (tid0 >> 5) * 8) * PW + PC_BQ + h * 256 + (tid0 & 31) * 8;
#pragma unroll
        for (int r = 0; r < 8; ++r) rq[r] = *(const u32x4*)(base + (size_t)r * PW);
    }
    for (int i = tid0; i < 16 * 528 / 4; i += 512) ((LAS unsigned*)NB)[i] = 0u;
    __syncthreads();
#pragma unroll 1
    for (int n = 0; n < 34; ++n) {
        int tid = tid0; asm volatile("" : "+v"(tid));
        const int w = tid >> 6, lane = tid & 63, fr = lane & 15, fq = lane >> 4, wm = w >> 2, wn = w & 3;
        const int cg = tid & 31, rg = tid >> 5, cg16 = tid & 15, rg32 = tid >> 4;
        const int R0 = M1_R0(n);
#pragma unroll
        for (int r = 0; r < 8; ++r) *(LAS u32x4*)(QN + (rg * 8 + r) * 528 + cg * 16) = rq[r];
        __builtin_amdgcn_sched_barrier(0);
#pragma unroll
        for (int mt = 0; mt < 4; ++mt)
#pragma unroll
            for (int nt = 0; nt < 4; ++nt) { u32x2 pk; pk.x = cvt_pk_bf16(Cst[mt][nt][0], Cst[mt][nt][1]); pk.y = cvt_pk_bf16(Cst[mt][nt][2], Cst[mt][nt][3]);
                *(LAS u32x2*)(CB + (64 * wm + 32 * (mt >> 1) + 16 * ((fr >> 2) & 1) + 4 * (2 * (mt & 1) + (fr >> 3)) + (fr & 3)) * 528 + (64 * wn + nt * 16 + 4 * fq) * 2) = pk; }
        if (fr == 0) {
#pragma unroll
            for (int nt = 0; nt < 2; ++nt) { u32x2 pk; pk.x = cvt_pk_bf16(nacc[0][nt][0], nacc[0][nt][1]); pk.y = cvt_pk_bf16(nacc[0][nt][2], nacc[0][nt][3]);
                *(LAS u32x2*)(NB + (32 * w + nt * 16 + 4 * fq) * 2) = pk; }
        }
        if (w == 0) {
            const GateScan gs = gate_scan(G, R0, dir, h, lane);
            const float y0 = gs.gi0 - gs.cb0, y1 = gs.gi1 - gs.cb1;
            float incl = fmaxf(y0, y1);
#pragma unroll
            for (int o = 1; o < 64; o <<= 1) { const float v = __shfl_up(incl, o); if (lane >= o) incl = fmaxf(incl, v); }
            float excl = __shfl_up(incl, 1); if (lane == 0) excl = -3.0e38f;
            const float a0 = fmaxf(excl, y0), a1 = incl;
            const float mt0 = gs.cb0 + fmaxf(m_prev, a0), mt1 = gs.cb1 + fmaxf(m_prev, a1);
            const float cl = __shfl(gs.cb1, 63), amax = __shfl(a1, 63);
            const float m_new = cl + fmaxf(m_prev, amax);
            einter[gs.t0] = __expf(gs.cb0 + m_prev - mt0); einter[gs.t1] = __expf(gs.cb1 + m_prev - mt1);
            wsv[gs.t0] = __expf(cl - gs.cb0 + gs.gi0 - m_new); wsv[gs.t1] = __expf(cl - gs.cb1 + gs.gi1 - m_new);
            if (lane == 0) scal[0] = __expf(cl + m_prev - m_new);
            if (sl == 0) { MT[((size_t)dir * MTOT + R0 + gs.t0) * 4 + h] = mt0; MT[((size_t)dir * MTOT + R0 + gs.t1) * 4 + h] = mt1; }
            m_prev = m_new;
        }
        {
            const bf16_t* kb = Pb + (size_t)(R0 + rg * 8) * PW + PC_BK + h * 256 + cg * 8;
#pragma unroll
            for (int r = 0; r < 8; ++r) rk[r] = *(const u32x4*)(kb + (size_t)r * PW);
            const bf16_t* vb = Pb + (size_t)(R0 + rg32 * 4) * PW + PC_BV + h * 256 + sl * 128 + cg16 * 8;
#pragma unroll
            for (int r = 0; r < 4; ++r) rv[r] = *(const u32x4*)(vb + (size_t)r * PW);
        }
        __syncthreads();
        {
            f32x4 o[4][2];
#pragma unroll
            for (int i = 0; i < 4; ++i) { o[i][0] = (f32x4){0.f, 0.f, 0.f, 0.f}; o[i][1] = o[i][0]; }
            mma_tile<4, 2, 8, false, false>(QN, 528, 64 * wm, CB, 528, 32 * wn, o, lane);
            f32x4 on[1][1]; on[0][0] = (f32x4){0.f, 0.f, 0.f, 0.f};
            mma_tile<1, 1, 8, false, false>(QN, 528, 16 * w, NB, 528, 0, on, lane);
#pragma unroll
            for (int mt = 0; mt < 4; ++mt) { const int t = 64 * wm + mt * 16 + fr; const float ei = einter[t];
                bf16_t* dstp = IM + ((size_t)dir * MTOT + R0 + t) * 1024 + h * 256 + sl * 128 + 32 * wn + 8 * fq;
                u32x4 pk; pk.x = cvt_pk_bf16(o[mt][0][0] * ei, o[mt][0][1] * ei); pk.y = cvt_pk_bf16(o[mt][0][2] * ei, o[mt][0][3] * ei);
                pk.z = cvt_pk_bf16(o[mt][1][0] * ei, o[mt][1][1] * ei); pk.w = cvt_pk_bf16(o[mt][1][2] * ei, o[mt][1][3] * ei);
                *(u32x4*)(dstp) = pk; }
            if (sl == 0 && fq == 0) { const int t = 16 * w + fr; DEN[((size_t)dir * MTOT + R0 + t) * 4 + h] = einter[t] * on[0][0][0]; }
        }
        __syncthreads();
#pragma unroll
        for (int r = 0; r < 8; ++r) *(LAS u32x4*)(QN + (rg * 8 + r) * 528 + cg * 16) = rk[r];
#pragma unroll
        for (int r = 0; r < 4; ++r) { float v8[8]; unpack8(rv[r], v8); const float wv = wsv[rg32 * 4 + r];
            u32x4 ov; ov.x = cvt_pk_bf16(v8[0] * wv, v8[1] * wv); ov.y = cvt_pk_bf16(v8[2] * wv, v8[3] * wv); ov.z = cvt_pk_bf16(v8[4] * wv, v8[5] * wv); ov.w = cvt_pk_bf16(v8[6] * wv, v8[7] * wv);
            *(LAS u32x4*)(CB + (rg32 * 4 + r) * 272 + cg16 * 16) = ov; }
        if (tid < 128) { const unsigned wbits = cvt_pk_bf16(wsv[tid], 0.f);
            *(LAS u32x4*)(WS16 + tid * 48) = (u32x4){wbits, 0u, 0u, 0u}; *(LAS u32x4*)(WS16 + tid * 48 + 16) = (u32x4){0u, 0u, 0u, 0u}; }
        __syncthreads();
        {
            const float ec = scal[0];
#pragma unroll
            for (int i = 0; i < 4; ++i)
#pragma unroll
                for (int j = 0; j < 4; ++j) Cst[i][j] *= ec;
            nacc[0][0] *= ec; nacc[0][1] *= ec;
            mma_tile<4, 4, 4, true, true>(CB, 272, 64 * wm, QN, 528, 64 * wn, Cst, lane);
            mma_tile<1, 2, 4, true, true>(WS16, 48, 0, QN, 528, 32 * w, nacc, lane);
        }
        if (n + 1 < 34) {
            const int R1 = M1_R0(n + 1);
            const bf16_t* qb = Pb + (size_t)(R1 + rg * 8) * PW + PC_BQ + h * 256 + cg * 8;
#pragma unroll
            for (int r = 0; r < 8; ++r) rq[r] = *(const u32x4*)(qb + (size_t)r * PW);
        }
        __syncthreads();
    }
#undef M1_R0
}

DI void task_m2(const Params& P, int l, int b, int h, int cpos, LAS u8* lds, int tid) {
    LAS u8* R1 = lds; LAS u8* R2 = lds + 69632; LAS float* sm = (LAS float*)(lds + 139264);
    const bf16_t* Pb = (const bf16_t*)(P.ws + WS_P); const float* G = (const float*)(P.ws + WS_GATES); bf16_t* mix = (bf16_t*)(P.ws + WS_N);
    const bf16_t* IM = (const bf16_t*)(P.ws + WS_IM); const float* MT = (const float*)(P.ws + WS_MT); const float* DEN = (const float*)(P.ws + WS_DEN);
    const int w = tid >> 6, lane = tid & 63, fr = lane & 15, fq = lane >> 4;
    const int R0 = (cpos < 2) ? (MLAT + b * CTXL + cpos * 128) : (b * SEQ + (cpos - 2) * 128);
    if (w < 2) {
        const int dir = w; const GateScan gs = gate_scan(G, R0, dir, h, lane);
        LAS float* q = sm + dir * 512;
        q[gs.t0] = gs.cb0; q[gs.t1] = gs.cb1; q[128 + gs.t0] = gs.gi0 - gs.cb0; q[128 + gs.t1] = gs.gi1 - gs.cb1;
        q[256 + gs.t0] = MT[((size_t)dir * MTOT + R0 + gs.t0) * 4 + h]; q[256 + gs.t1] = MT[((size_t)dir * MTOT + R0 + gs.t1) * 4 + h];
        q[384 + gs.t0] = DEN[((size_t)dir * MTOT + R0 + gs.t0) * 4 + h]; q[384 + gs.t1] = DEN[((size_t)dir * MTOT + R0 + gs.t1) * 4 + h];
    }
    stage_plain<false>(Pb, R0, PC_BQ + h * 256, R1, tid);
    stage_plain<false>(Pb, R0, PC_BK + h * 256, R2, tid);
    __syncthreads();
    const int t = 16 * w + fr;
    float rNf, rNb;
    unsigned pp[8][2];
    {
        f32x4 s[8];
#pragma unroll
        for (int i = 0; i < 8; ++i) s[i] = (f32x4){0.f, 0.f, 0.f, 0.f};
        mma_rows<8, 8>(R1, 528, 16 * w, R2, 528, 0, s, fr, fq);
        const float cbf_t = sm[t], mtf_t = sm[256 + t], dnf_t = sm[384 + t], cbb_t = sm[512 + t], mtb_t = sm[768 + t], dnb_t = sm[896 + t];
        float vf[8][4], vb[8][4]; float sumf = 0.f, sumb = 0.f;
#pragma unroll
        for (int nt = 0; nt < 8; ++nt) { const f32x4 bif = *(const LAS f32x4*)(sm + 128 + nt * 16 + 4 * fq), bib = *(const LAS f32x4*)(sm + 640 + nt * 16 + 4 * fq);
#pragma unroll
            for (int j = 0; j < 4; ++j) { const int si = nt * 16 + 4 * fq + j;
                const float wf = __uint_as_float(__float_as_uint(__expf(cbf_t + bif[j] - mtf_t)) & ~(unsigned)((t - si) >> 31));
                const float wb = __uint_as_float(__float_as_uint(__expf(cbb_t + bib[j] - mtb_t)) & ~(unsigned)((si - t) >> 31));
                vf[nt][j] = s[nt][j] * wf; vb[nt][j] = s[nt][j] * wb; sumf += vf[nt][j]; sumb += vb[nt][j]; } }
        sumf += __shfl_xor(sumf, 16); sumf += __shfl_xor(sumf, 32); sumb += __shfl_xor(sumb, 16); sumb += __shfl_xor(sumb, 32);
        rNf = rcpf_(fmaxf(fabsf(sumf + dnf_t), __expf(-mtf_t))); rNb = rcpf_(fmaxf(fabsf(sumb + dnb_t), __expf(-mtb_t)));
#pragma unroll
        for (int nt = 0; nt < 8; ++nt) { pp[nt][0] = cvt_pk_bf16(vf[nt][0] * rNf + vb[nt][0] * rNb, vf[nt][1] * rNf + vb[nt][1] * rNb);
            pp[nt][1] = cvt_pk_bf16(vf[nt][2] * rNf + vb[nt][2] * rNb, vf[nt][3] * rNf + vb[nt][3] * rNb); }
    }
    __syncthreads();
#pragma unroll
    for (int nt = 0; nt < 8; ++nt) { u32x2 pk; pk.x = pp[nt][0]; pk.y = pp[nt][1]; *(LAS u32x2*)(R1 + t * 272 + (nt * 16 + 4 * fq) * 2) = pk; }
    {
        const int cg = tid & 31, rg = tid >> 5;
        const bf16_t* vp = Pb + (size_t)(R0 + rg * 8) * PW + PC_BV + h * 256 + cg * 8;
        u32x4 raw[8];
#pragma unroll
        for (int r = 0; r < 8; ++r) raw[r] = *(const u32x4*)(vp + (size_t)r * PW);
#pragma unroll
        for (int c = 0; c < 8; ++c) { u32x4 v; const int cw = c >> 1, hi = c & 1;
            v.x = half_sel(raw[0][cw], hi) | (half_sel(raw[1][cw], hi) << 16); v.y = half_sel(raw[2][cw], hi) | (half_sel(raw[3][cw], hi) << 16);
            v.z = half_sel(raw[4][cw], hi) | (half_sel(raw[5][cw], hi) << 16); v.w = half_sel(raw[6][cw], hi) | (half_sel(raw[7][cw], hi) << 16);
            *(LAS u32x4*)(R2 + (32 * (cg >> 2) + 16 * ((c >> 2) & 1) + 4 * (cg & 3) + (c & 3)) * 272 + (rg * 8) * 2) = v; }
    }
    __syncthreads();
    {
        f32x4 o[16];
#pragma unroll
        for (int i = 0; i < 16; ++i) o[i] = (f32x4){0.f, 0.f, 0.f, 0.f};
        mma_rows<16, 4>(R1, 272, 16 * w, R2, 272, 0, o, fr, fq);
        const size_t R = (size_t)(R0 + t);
        const bf16_t* imf = IM + R * 1024 + h * 256; const bf16_t* imb = IM + ((size_t)MTOT + R) * 1024 + h * 256;
        float ssq = 0.f;
#pragma unroll
        for (int gp = 0; gp < 8; ++gp) { const int e = gp * 32 + 8 * fq;
            const u32x4 a = *(const u32x4*)(imf + e), c = *(const u32x4*)(imb + e);
            float af[8], cf[8]; unpack8(a, af); unpack8(c, cf);
#pragma unroll
            for (int j = 0; j < 4; ++j) { o[2 * gp][j] += af[j] * rNf + cf[j] * rNb; o[2 * gp + 1][j] += af[4 + j] * rNf + cf[4 + j] * rNb;
                ssq += o[2 * gp][j] * o[2 * gp][j] + o[2 * gp + 1][j] * o[2 * gp + 1][j]; } }
        ssq += __shfl_xor(ssq, 16); ssq += __shfl_xor(ssq, 32);
        const float rstd = rsqrtf(ssq * (1.0f / 256.0f) + EPS);
        const float* mg = P.in[12] + l * 1024 + h * 256;
#pragma unroll
        for (int gp = 0; gp < 8; ++gp) { const int e = gp * 32 + 8 * fq;
            const f32x4 g0 = *(const f32x4*)(mg + e), g1 = *(const f32x4*)(mg + e + 4);
            const u32x4 bo = *(const u32x4*)(Pb + R * PW + PC_BO + h * 256 + e), bz = *(const u32x4*)(Pb + R * PW + PC_BZ + h * 256 + e);
            float bof[8], bzf[8]; unpack8(bo, bof); unpack8(bz, bzf);
            float y[8];
#pragma unroll
            for (int j = 0; j < 4; ++j) { y[j] = o[2 * gp][j] * rstd * g0[j] * sigmoidf_(bof[j]) * siluf_(bzf[j]); y[4 + j] = o[2 * gp + 1][j] * rstd * g1[j] * sigmoidf_(bof[4 + j]) * siluf_(bzf[4 + j]); }
            u32x4 pk; pk.x = cvt_pk_bf16(y[0], y[1]); pk.y = cvt_pk_bf16(y[2], y[3]); pk.z = cvt_pk_bf16(y[4], y[5]); pk.w = cvt_pk_bf16(y[6], y[7]);
            *(u32x4*)(mix + R * DM + 512 + h * 256 + e) = pk; }
    }
    __syncthreads();
}

DI void hgrn_gate16(const u32x4 z0, const u32x4 z1, const float (&lbv)[16], float (&kk)[16], LAS float* lfrow) {
    float z[16]; { float a[8], b[8]; unpack8(z0, a); unpack8(z1, b);
#pragma unroll
        for (int j = 0; j < 8; ++j) { z[j] = a[j]; z[8 + j] = b[j]; } }
    float lf[16];
#pragma unroll
    for (int j = 0; j < 16; ++j) { const float f = fmaxf(lbv[j] + (1.0f - lbv[j]) * sigmoidf_(z[j]), 1e-30f); lf[j] = __logf(f); kk[j] = 1.0f - f; }
#pragma unroll
    for (int j = 0; j < 4; ++j) *(LAS f32x4*)(lfrow + 4 * j) = (f32x4){lf[4 * j], lf[4 * j + 1], lf[4 * j + 2], lf[4 * j + 3]};
}

DI void task_hpre(const Params& P, int l, int b, int hd, int cpos, LAS u8* lds, int tid) {
    LAS float* lf = (LAS float*)lds; LAS u8* qd = lds + 32768; LAS u8* kd = lds + 50176; LAS u8* vN = lds + 67584; LAS u8* Pm = lds + 84992; LAS float* tot = (LAS float*)(lds + 94208);
    bf16_t* Pb = (bf16_t*)(P.ws + WS_P); bf16_t* OI = (bf16_t*)(P.ws + WS_OI); bf16_t* QB = (bf16_t*)(P.ws + WS_QB);
    float* DEC = (float*)(P.ws + WS_DEC) + (size_t)(((b * 4 + hd) * 68 + cpos) * 2) * 128;
    const float* lb = (const float*)(P.ws + WS_LB) + l * 512 + hd * 128;
    const int w = tid >> 6, lane = tid & 63, fr = lane & 15, fq = lane >> 4;
    const int i = tid >> 3, cg = tid & 7, c0 = cg * 16;
    int rbase, rstride;
    if (cpos < 4) { rbase = MLAT + b * CTXL + cpos * 64; rstride = 1; } else { rbase = b * SEQ + (cpos - 4); rstride = 64; }
    float lbv[16];
#pragma unroll
    for (int j = 0; j < 16; ++j) lbv[j] = lb[c0 + j];
    bf16_t* prow = Pb + (size_t)(rbase + i * rstride) * PW + hd * 128 + c0;
    float q[16];
    { const u32x4 q0 = *(const u32x4*)(prow + PC_CQ), q1 = *(const u32x4*)(prow + PC_CQ + 8); float a[8], c[8]; unpack8(q0, a); unpack8(q1, c);
#pragma unroll
        for (int j = 0; j < 8; ++j) { q[j] = siluf_(a[j]); q[8 + j] = siluf_(c[j]); } }
    { const u32x4 v0 = *(const u32x4*)(prow + PC_CI), v1 = *(const u32x4*)(prow + PC_CI + 8);
        *(LAS u32x4*)(vN + i * 272 + c0 * 2) = v0; *(LAS u32x4*)(vN + i * 272 + c0 * 2 + 16) = v1; }
    const u32x4 zf0 = *(const u32x4*)(prow + PC_CFF), zf1 = *(const u32x4*)(prow + PC_CFF + 8);
    const u32x4 zb0 = *(const u32x4*)(prow + PC_CFB), zb1 = *(const u32x4*)(prow + PC_CFB + 8);
    f32x4 sc[2]; sc[0] = (f32x4){0.f, 0.f, 0.f, 0.f}; sc[1] = sc[0];
    const int ii = 16 * (w >> 1) + fr;
#pragma unroll 1
    for (int d = 0; d < 2; ++d) {
        float kk[16];
        hgrn_gate16(d ? zb0 : zf0, d ? zb1 : zf1, lbv, kk, lf + i * 128 + c0);
        __syncthreads();
        {
            const int c = tid & 127, part = tid >> 7;
            float x[16];
#pragma unroll
            for (int k = 0; k < 16; ++k) { const int sidx = part * 16 + k; const int i2 = d ? 63 - sidx : sidx; x[k] = lf[i2 * 128 + c]; }
#pragma unroll
            for (int k = 1; k < 16; ++k) x[k] += x[k - 1];
            tot[part * 128 + c] = x[15];
            __syncthreads();
            float off = 0.f;
#pragma unroll
            for (int pp = 0; pp < 3; ++pp) off += (pp < part) ? tot[pp * 128 + c] : 0.f;
#pragma unroll
            for (int k = 0; k < 16; ++k) { const int sidx = part * 16 + k; const int i2 = d ? 63 - sidx : sidx; lf[i2 * 128 + c] = x[k] + off; }
            if (part == 3) DEC[d * 128 + c] = __expf(x[15] + off);
        }
        __syncthreads();
        {
            const int ilast = d ? 0 : 63;
            unsigned qo[8], ko[8], qs[8], ks[8];
#pragma unroll
            for (int j = 0; j < 16; j += 2) {
                const float cb0 = lf[i * 128 + c0 + j], cb1 = lf[i * 128 + c0 + j + 1], rf0 = lf[32 * 128 + c0 + j], rf1 = lf[32 * 128 + c0 + j + 1];
                const float cl0 = lf[ilast * 128 + c0 + j], cl1 = lf[ilast * 128 + c0 + j + 1];
                qo[j >> 1] = cvt_pk_bf16(q[j] * __expf(cb0 - rf0), q[j + 1] * __expf(cb1 - rf1));
                ko[j >> 1] = cvt_pk_bf16(kk[j] * __expf(rf0 - cb0), kk[j + 1] * __expf(rf1 - cb1));
                qs[j >> 1] = cvt_pk_bf16(q[j] * __expf(cb0), q[j + 1] * __expf(cb1));
                ks[j >> 1] = cvt_pk_bf16(kk[j] * __expf(cl0 - cb0), kk[j + 1] * __expf(cl1 - cb1)); }
            *(LAS u32x4*)(qd + i * 272 + c0 * 2) = (u32x4){qo[0], qo[1], qo[2], qo[3]}; *(LAS u32x4*)(qd + i * 272 + c0 * 2 + 16) = (u32x4){qo[4], qo[5], qo[6], qo[7]};
            *(LAS u32x4*)(kd + i * 272 + c0 * 2) = (u32x4){ko[0], ko[1], ko[2], ko[3]}; *(LAS u32x4*)(kd + i * 272 + c0 * 2 + 16) = (u32x4){ko[4], ko[5], ko[6], ko[7]};
            bf16_t* qdst = d ? QB + (size_t)(rbase + i * rstride) * 512 + hd * 128 + c0 : prow + PC_CQ;
            bf16_t* kdst = prow + (d ? PC_CFB : PC_CFF);
            *(u32x4*)(qdst) = (u32x4){qs[0], qs[1], qs[2], qs[3]}; *(u32x4*)(qdst + 8) = (u32x4){qs[4], qs[5], qs[6], qs[7]};
            *(u32x4*)(kdst) = (u32x4){ks[0], ks[1], ks[2], ks[3]}; *(u32x4*)(kdst + 8) = (u32x4){ks[4], ks[5], ks[6], ks[7]};
        }
        __syncthreads();
        {
            f32x4 s2[2]; s2[0] = (f32x4){0.f, 0.f, 0.f, 0.f}; s2[1] = s2[0];
            mma_rows<2, 4>(qd, 272, 16 * (w >> 1), kd, 272, 32 * (w & 1), s2, fr, fq);
#pragma unroll
            for (int nt = 0; nt < 2; ++nt)
#pragma unroll
                for (int j = 0; j < 4; ++j) { const int jj = 32 * (w & 1) + nt * 16 + 4 * fq + j; const int df = d ? (jj - ii) : (ii - jj); sc[nt][j] += __uint_as_float(__float_as_uint(s2[nt][j]) & ~(unsigned)(df >> 31)); }
        }
        __syncthreads();
    }
#pragma unroll
    for (int nt = 0; nt < 2; ++nt) { u32x2 pk; pk.x = cvt_pk_bf16(sc[nt][0], sc[nt][1]); pk.y = cvt_pk_bf16(sc[nt][2], sc[nt][3]);
        *(LAS u32x2*)(Pm + ii * 144 + (32 * (w & 1) + nt * 16 + 4 * fq) * 2) = pk; }
    __syncthreads();
    {
        f32x4 o[4];
#pragma unroll
        for (int j = 0; j < 4; ++j) o[j] = (f32x4){0.f, 0.f, 0.f, 0.f};
        mma_gen<4, 2, false, true>(Pm, 144, 16 * (w & 3), vN, 272, 64 * (w >> 2), o, lane);
        const int io = 16 * (w & 3) + fr; const size_t Ro = (size_t)(rbase + io * rstride);
        bf16_t* dstp = OI + Ro * 512 + hd * 128 + 64 * (w >> 2);
#pragma unroll
        for (int nt = 0; nt < 4; ++nt) { u32x2 pk; pk.x = cvt_pk_bf16(o[nt][0], o[nt][1]); pk.y = cvt_pk_bf16(o[nt][2], o[nt][3]); *(u32x2*)(dstp + nt * 16 + 4 * fq) = pk; }
    }
    __syncthreads();
}

DI void task_h1(const Params& P, int l, int task, LAS u8* lds, const int tid0) {
    const int b = task >> 3, hd = (task >> 1) & 3, dir = task & 1;
    LAS u8* qh = lds; LAS u8* kh = lds + 17408; LAS u8* vN = lds + 34816; LAS u8* SB = lds + 52224;
    const bf16_t* Pb = (const bf16_t*)(P.ws + WS_P); const bf16_t* QB = (const bf16_t*)(P.ws + WS_QB); bf16_t* IH = (bf16_t*)(P.ws + WS_IH);
    const float* DECb = (const float*)(P.ws + WS_DEC) + (size_t)((b * 4 + hd) * 68) * 256 + dir * 128;
    f32x4 st[8];
#pragma unroll
    for (int j = 0; j < 8; ++j) st[j] = (f32x4){0.f, 0.f, 0.f, 0.f};
    u32x4 rq0, rq1, rk0, rk1, rv0, rv1; f32x4 dc[8];
#define H1_LOAD(n_) do { const int n__ = (n_); int rb_, rs_, cp_; \
        if (n__ < 4) { const int cc = dir ? 3 - n__ : n__; rb_ = MLAT + b * CTXL + cc * 64; rs_ = 1; cp_ = cc; } \
        else { const int wc = dir ? 63 - (n__ - 4) : n__ - 4; rb_ = b * SEQ + wc; rs_ = 64; cp_ = 4 + wc; } \
        const int i_ = tid0 >> 3, c0_ = (tid0 & 7) * 16; const size_t R_ = (size_t)(rb_ + i_ * rs_); \
        const bf16_t* pr_ = Pb + R_ * PW + hd * 128 + c0_; \
        const bf16_t* qp_ = dir ? QB + R_ * 512 + hd * 128 + c0_ : pr_ + PC_CQ; \
        rq0 = *(const u32x4*)(qp_); rq1 = *(const u32x4*)(qp_ + 8); \
        rk0 = *(const u32x4*)(pr_ + (dir ? PC_CFB : PC_CFF)); rk1 = *(const u32x4*)(pr_ + (dir ? PC_CFB : PC_CFF) + 8); \
        rv0 = *(const u32x4*)(pr_ + PC_CI); rv1 = *(const u32x4*)(pr_ + PC_CI + 8); \
        const int fq_ = (tid0 & 63) >> 4; \
        _Pragma("unroll") for (int nt = 0; nt < 8; ++nt) dc[nt] = *(const f32x4*)(DECb + (size_t)cp_ * 256 + nt * 16 + 4 * fq_); } while (0)
    H1_LOAD(0);
#pragma unroll 1
    for (int n = 0; n < 68; ++n) {
        int tid = tid0; asm volatile("" : "+v"(tid));
        const int w = tid >> 6, lane = tid & 63, fr = lane & 15, fq = lane >> 4;
        const int i = tid >> 3, c0 = (tid & 7) * 16;
        int rbase, rstride;
        if (n < 4) { const int cc = dir ? 3 - n : n; rbase = MLAT + b * CTXL + cc * 64; rstride = 1; }
        else { const int wc = dir ? 63 - (n - 4) : n - 4; rbase = b * SEQ + wc; rstride = 64; }
        *(LAS u32x4*)(qh + i * 272 + c0 * 2) = rq0; *(LAS u32x4*)(qh + i * 272 + c0 * 2 + 16) = rq1;
        *(LAS u32x4*)(kh + i * 272 + c0 * 2) = rk0; *(LAS u32x4*)(kh + i * 272 + c0 * 2 + 16) = rk1;
        *(LAS u32x4*)(vN + i * 272 + c0 * 2) = rv0; *(LAS u32x4*)(vN + i * 272 + c0 * 2 + 16) = rv1;
        {
            const int e = 32 * (w >> 1) + 16 * ((fr >> 2) & 1) + 4 * (2 * (w & 1) + (fr >> 3)) + (fr & 3);
#pragma unroll
            for (int nt = 0; nt < 8; ++nt) { u32x2 pk; pk.x = cvt_pk_bf16(st[nt][0], st[nt][1]); pk.y = cvt_pk_bf16(st[nt][2], st[nt][3]);
                *(LAS u32x2*)(SB + e * 272 + (nt * 16 + 4 * fq) * 2) = pk; }
        }
        f32x4 dcur[8];
#pragma unroll
        for (int nt = 0; nt < 8; ++nt) dcur[nt] = dc[nt];
        if (n + 1 < 68) H1_LOAD(n + 1);
        __syncthreads();
        {
            f32x4 o[4];
#pragma unroll
            for (int j = 0; j < 4; ++j) o[j] = (f32x4){0.f, 0.f, 0.f, 0.f};
            mma_rows<4, 4>(qh, 272, 16 * (w & 3), SB, 272, 64 * (w >> 2), o, fr, fq);
            const int io = 16 * (w & 3) + fr;
            bf16_t* dstp = IH + ((size_t)dir * MTOT + rbase + io * rstride) * 512 + hd * 128 + 64 * (w >> 2);
#pragma unroll
            for (int gp = 0; gp < 2; ++gp) { u32x4 pk; pk.x = cvt_pk_bf16(o[2 * gp][0], o[2 * gp][1]); pk.y = cvt_pk_bf16(o[2 * gp][2], o[2 * gp][3]);
                pk.z = cvt_pk_bf16(o[2 * gp + 1][0], o[2 * gp + 1][1]); pk.w = cvt_pk_bf16(o[2 * gp + 1][2], o[2 * gp + 1][3]); *(u32x4*)(dstp + gp * 32 + 8 * fq) = pk; }
#pragma unroll
            for (int nt = 0; nt < 8; ++nt) st[nt] *= dcur[nt];
            mma_gen<8, 2, true, true>(vN, 272, 16 * w, kh, 272, 0, st, lane);
        }
        __syncthreads();
    }
#undef H1_LOAD
}

DI void phase_hpost(const Params& P, int l, int nrows, int tid, int bfirst, int nblk) {
    const bf16_t* Pb = (const bf16_t*)(P.ws + WS_P); const bf16_t* IH = (const bf16_t*)(P.ws + WS_IH); const bf16_t* OI = (const bf16_t*)(P.ws + WS_OI);
    bf16_t* mix = (bf16_t*)(P.ws + WS_N);
    const int w = tid >> 6, lane = tid & 63;
    const float* hg = P.in[14] + l * 512 + lane * 8;
    const f32x4 g0 = *(const f32x4*)(hg), g1 = *(const f32x4*)(hg + 4);
    if ((int)blockIdx.x < bfirst) return;
    for (int R = ((int)blockIdx.x - bfirst) * 8 + w; R < nrows; R += nblk * 8) {
        const u32x4 a = __builtin_nontemporal_load((const u32x4*)(OI + (size_t)R * 512 + lane * 8)), f = __builtin_nontemporal_load((const u32x4*)(IH + (size_t)R * 512 + lane * 8)), bb = __builtin_nontemporal_load((const u32x4*)(IH + ((size_t)MTOT + R) * 512 + lane * 8));
        const u32x4 gz = __builtin_nontemporal_load((const u32x4*)(Pb + (size_t)R * PW + PC_CG + lane * 8));
        float x[8], y[8], z[8], gg[8]; unpack8(a, x); unpack8(f, y); unpack8(bb, z); unpack8(gz, gg);
        float ssq = 0.f;
#pragma unroll
        for (int j = 0; j < 8; ++j) { x[j] += y[j] + z[j]; ssq += x[j] * x[j]; }
        ssq += __shfl_xor(ssq, 1); ssq += __shfl_xor(ssq, 2); ssq += __shfl_xor(ssq, 4); ssq += __shfl_xor(ssq, 8);
        const float rstd = rsqrtf(ssq * (1.0f / 128.0f) + EPS);
        u32x4 o;
        o.x = cvt_pk_bf16(x[0] * rstd * g0[0] * siluf_(gg[0]), x[1] * rstd * g0[1] * siluf_(gg[1]));
        o.y = cvt_pk_bf16(x[2] * rstd * g0[2] * siluf_(gg[2]), x[3] * rstd * g0[3] * siluf_(gg[3]));
        o.z = cvt_pk_bf16(x[4] * rstd * g1[0] * siluf_(gg[4]), x[5] * rstd * g1[1] * siluf_(gg[5]));
        o.w = cvt_pk_bf16(x[6] * rstd * g1[2] * siluf_(gg[6]), x[7] * rstd * g1[3] * siluf_(gg[7]));
        *(u32x4*)(mix + (size_t)R * DM + 1536 + lane * 8) = o;
    }
}

DI void phase_final(const Params& P, int tid) {
    const float* fg = P.in[16]; float* out = P.out; const bf16_t* hf = (const bf16_t*)(P.ws + WS_P);
    const int w = tid >> 6, lane = tid & 63;
    f32x4 g[8];
#pragma unroll
    for (int i = 0; i < 8; ++i) g[i] = *(const f32x4*)(fg + (i * 64 + lane) * 4);
    for (int row = blockIdx.x * 8 + w; row < MLAT; row += gridDim.x * 8) {
        float* p = out + (size_t)row * DM; const bf16_t* ph = hf + (size_t)row * DM;
        f32x4 x[8]; float ss = 0.f;
#pragma unroll
        for (int i = 0; i < 8; ++i) { const u32x2 r2 = __builtin_nontemporal_load((const u32x2*)(ph + (i * 64 + lane) * 4)); x[i] = (f32x4){bf_lo(r2.x), bf_hi(r2.x), bf_lo(r2.y), bf_hi(r2.y)}; ss += x[i][0] * x[i][0] + x[i][1] * x[i][1] + x[i][2] * x[i][2] + x[i][3] * x[i][3]; }
#pragma unroll
        for (int o = 32; o >= 1; o >>= 1) ss += __shfl_xor(ss, o);
        const float rstd = rsqrtf(ss * (1.0f / DM) + EPS);
#pragma unroll
        for (int i = 0; i < 8; ++i) *(f32x4*)(p + (i * 64 + lane) * 4) = x[i] * rstd * g[i];
    }
}

DI void grid_bar(unsigned* cnt, unsigned target) {
    asm volatile("s_waitcnt vmcnt(0) lgkmcnt(0)" ::: "memory");
    __syncthreads();
    if (threadIdx.x < 64) {
        __builtin_amdgcn_fence(__ATOMIC_RELEASE, "agent");
        if (threadIdx.x == 0) {
            __hip_atomic_fetch_add(cnt, 1u, __ATOMIC_RELAXED, __HIP_MEMORY_SCOPE_AGENT);
            while (__hip_atomic_load(cnt, __ATOMIC_RELAXED, __HIP_MEMORY_SCOPE_AGENT) < target) __builtin_amdgcn_s_sleep(1);
        }
        __builtin_amdgcn_fence(__ATOMIC_ACQUIRE, "agent");
        asm volatile("s_waitcnt vmcnt(0)" ::: "memory");
    }
    __syncthreads();
}
DI unsigned xcc_id() { return (unsigned)__builtin_amdgcn_s_getreg((3 << 11) | 20) & 0xFu; }
DI void xcd_bar(unsigned* bar, unsigned nb, unsigned xcc, unsigned xcnt, unsigned nxcc) {
    asm volatile("s_waitcnt vmcnt(0) lgkmcnt(0)" ::: "memory");
    __syncthreads();
    if (threadIdx.x < 64) {
        if (threadIdx.x == 0) {
            const unsigned old = __hip_atomic_fetch_add(bar + 640 + 64 * xcc, 1u, __ATOMIC_RELAXED, __HIP_MEMORY_SCOPE_AGENT);
            if (old + 1u == nb * xcnt) {
                __builtin_amdgcn_fence(__ATOMIC_RELEASE, "agent");
                asm volatile("s_waitcnt vmcnt(0)" ::: "memory");
                __hip_atomic_fetch_add(bar + 1216, 1u, __ATOMIC_RELAXED, __HIP_MEMORY_SCOPE_AGENT);
            }
            unsigned spins = 0;
            while (__hip_atomic_load(bar + 1216, __ATOMIC_RELAXED, __HIP_MEMORY_SCOPE_AGENT) < nb * nxcc && ++spins < (1u << 22)) __builtin_amdgcn_s_sleep(1);
        }
        __builtin_amdgcn_fence(__ATOMIC_ACQUIRE, "agent");
        asm volatile("s_waitcnt vmcnt(0)" ::: "memory");
    }
    __syncthreads();
}
typedef const __attribute__((address_space(4))) Params* KargP;
#if defined(__HIP_DEVICE_COMPILE__)
DI Params fresh_params() { KargP pp = (KargP)__builtin_amdgcn_kernarg_segment_ptr(); asm volatile("" : "+s"(pp)); Params r;
#pragma unroll
    for (int i = 0; i < 17; ++i) r.in[i] = pp->in[i];
    r.out = pp->out; r.ws = pp->ws; return r; }
#else
DI Params fresh_params() { return Params{}; }
#endif

__global__ void __launch_bounds__(512, 2) mega_fwd(Params Pk) {
    extern __shared__ __attribute__((aligned(16))) u8 lds_raw[];
    LAS u8* lds = (LAS u8*)lds_raw;
    cg::grid_group grid = cg::this_grid();
    const int G = gridDim.x;
    unsigned nbar = 0;
    grid.sync();
    unsigned my_xcc, my_xcnt, n_xcc;
    {
        const Params Pb_ = fresh_params(); unsigned* bar = (unsigned*)(Pb_.ws + WS_BAR);
        my_xcc = __builtin_amdgcn_readfirstlane(xcc_id()) & 7u;
        if (threadIdx.x == 0) __hip_atomic_fetch_add(bar + 64 + 64 * my_xcc, 1u, __ATOMIC_RELAXED, __HIP_MEMORY_SCOPE_AGENT);
        grid_bar(bar, (unsigned)G);
        my_xcnt = __hip_atomic_load(bar + 64 + 64 * my_xcc, __ATOMIC_RELAXED, __HIP_MEMORY_SCOPE_AGENT);
        n_xcc = 0;
        for (int j = 0; j < 8; ++j) n_xcc += (__hip_atomic_load(bar + 64 + 64 * j, __ATOMIC_RELAXED, __HIP_MEMORY_SCOPE_AGENT) != 0u) ? 1u : 0u;
    }
#define GRID_SYNC() do { const Params Pb_ = fresh_params(); ++nbar; xcd_bar((unsigned*)(Pb_.ws + WS_BAR), nbar, my_xcc, my_xcnt, n_xcc); } while (0)
#define FRESH_TID int tid = threadIdx.x; asm volatile("" : "+v"(tid))

    { FRESH_TID; const Params P = fresh_params(); phase0(P, lds, tid); }
    GRID_SYNC();
#pragma unroll 1
    for (int l = 0; l < DEPTH; ++l) {
        const bool last = (l == DEPTH - 1);
        { FRESH_TID; const Params P = fresh_params(); phase1(P, l, lds, tid); }
        GRID_SYNC();
        {
            FRESH_TID; const Params P = fresh_params();
            pg8::Gemm g{(const bf16_t*)(P.ws + WS_N), (const bf16_t*)(P.ws + WS_WIN), MTOT, NGEMM, DM};
            pg8::StaticOrder S; S.init(MTOT, NGEMM, G, (int)blockIdx.x, P2_WGM);
            pg8::EpiP E{(bf16_t*)(P.ws + WS_P), (float*)(P.ws + WS_GATES), P.in[8] + (size_t)l * DIN, (bf16_t*)(P.ws + WS_HALO)};
            pg8::gemm_phase<pg8::EpiP>(lds, g, S, E, tid);
        }
        GRID_SYNC();
        {
            FRESH_TID; const Params P = fresh_params();
            const int n_pre = (G == 256) ? 1472 : 2176;
            for (int task = blockIdx.x; task < n_pre + 272 * 8; task += G) {
                int tl = tid; asm volatile("" : "+v"(tl));
                if (task < n_pre) task_hpre(P, l, task / 272, (task / 68) & 3, task % 68, lds, tl);
                else { const int a = task - n_pre; task_conv(P, l, a >> 3, (a >> 2) & 1, a & 3, tl); }
            }
        }
        GRID_SYNC();
        {
            FRESH_TID; const Params P = fresh_params();
            const int nA = last ? 1024 : 1088;
            const int bx = blockIdx.x;
            if (G == 256) {
                if (bx < 128) { int tl = tid; asm volatile("" : "+v"(tl)); task_m1(P, l, bx, lds, tl); }
                else {
                    const int hb = bx - 128;
                    {
                        const int t_first = (hb < 64) ? 1472 + hb : 1472 + 256 + (hb - 64), t_cnt = (hb < 64) ? 4 : 7;
                        for (int k = 0; k < t_cnt; ++k) { const int t2 = t_first + 64 * k; int tl = tid; asm volatile("" : "+v"(tl)); task_hpre(P, l, t2 / 272, (t2 / 68) & 3, t2 % 68, lds, tl); }
                    }
                    grid_bar((unsigned*)(P.ws + WS_BAR + 6144), (unsigned)(l + 1) * 128u);
                    if (hb < 64) { int tl = tid; asm volatile("" : "+v"(tl)); task_h1(P, l, hb, lds, tl); }
                    else { for (int a = hb - 64; a < nA; a += 64) { int tl = tid; asm volatile("" : "+v"(tl)); task_chunkmlp(P, l, a >> 2, a & 3, lds, tl); } }
                }
            }
            else if (bx < 128 && G >= 192) { int tl = tid; asm volatile("" : "+v"(tl)); task_m1(P, l, bx, lds, tl); }
            else {
                if (G < 192) { for (int t2 = bx; t2 < 128; t2 += G) { int tl = tid; asm volatile("" : "+v"(tl)); task_m1(P, l, t2, lds, tl); } }
                const int hb = (G >= 192) ? bx - 128 : bx, hs = (G >= 192) ? G - 128 : G;
                for (int t2 = hb; t2 < 64; t2 += hs) { int tl = tid; asm volatile("" : "+v"(tl)); task_h1(P, l, t2, lds, tl); }
                for (int a = hb; a < nA; a += hs) { int tl = tid; asm volatile("" : "+v"(tl)); task_chunkmlp(P, l, a >> 2, a & 3, lds, tl); }
            }
        }
        GRID_SYNC();
        {
            FRESH_TID; const Params P = fresh_params();
            const int nM2 = last ? 1024 : 1088;
            for (int task = blockIdx.x; task < nM2; task += G) {
                int tl = tid; asm volatile("" : "+v"(tl));
                int b, h, cpos;
                if (last) { cpos = 2 + (task & 31); h = (task >> 5) & 3; b = task >> 7; } else { cpos = task % 34; h = (task / 34) & 3; b = task / 136; }
                task_m2(P, l, b, h, cpos, lds, tl);
            }
            {
                const int nfull = nM2 % G; const int bfirst = (nfull > 0 && nfull < G) ? nfull : 0;
                phase_hpost(P, l, last ? MLAT : MTOT, tid, bfirst, G - bfirst);
            }
        }
        GRID_SYNC();
        {
            FRESH_TID; const Params P = fresh_params();
            const int M = last ? MLAT : MTOT;
            pg8::Gemm g{(const bf16_t*)(P.ws + WS_N), (const bf16_t*)(P.ws + WS_WOUT), M, DM, DM};
            pg8::StaticOrder S; S.init(M, DM, G, (int)blockIdx.x, 4);
            pg8::EpiH E{P.in[0], (bf16_t*)P.out, (bf16_t*)(P.ws + WS_P), l == 0 ? P.in[2] : (const float*)(P.ws + WS_HCTX), (float*)(P.ws + WS_HCTX),
                        (const float*)(P.ws + WS_MOD) + (size_t)l * 9 * 6144, l == 0 ? 1 : 0, last ? 1 : 0};
            pg8::gemm_phase<pg8::EpiH>(lds, g, S, E, tid);
        }
        GRID_SYNC();
    }
    { FRESH_TID; const Params P = fresh_params(); phase_final(P, tid); }
}

extern "C" void kernel_launch(void* const* d_in, const int* in_sizes, int n_in, void* d_out, int out_size, void* d_ws, size_t ws_size, hipStream_t stream) {
    static int grid_blocks = 0;
    if (grid_blocks == 0) {
        if (ws_size < WS_END) { fprintf(stderr, "kernel_launch: workspace too small: %zu < %zu\n", ws_size, (size_t)WS_END); grid_blocks = -1; return; }
        int dev = 0, cus = 0, per_cu = 0;
        (void)hipGetDevice(&dev);
        (void)hipDeviceGetAttribute(&cus, hipDeviceAttributeMultiprocessorCount, dev);
        if (hipFuncSetAttribute((const void*)mega_fwd, hipFuncAttributeMaxDynamicSharedMemorySize, LDS_BYTES) != hipSuccess) { fprintf(stderr, "kernel_launch: hipFuncSetAttribute failed\n"); grid_blocks = -1; return; }
        if (hipOccupancyMaxActiveBlocksPerMultiprocessor(&per_cu, (const void*)mega_fwd, 512, LDS_BYTES) != hipSuccess || per_cu < 1) { fprintf(stderr, "kernel_launch: occupancy query says %d\n", per_cu); per_cu = 1; }
        (void)hipGetLastError();
        grid_blocks = cus * per_cu;
    }
    if (grid_blocks < 0) return;
    (void)hipMemsetAsync((u8*)d_ws + WS_BAR, 0, 8192, stream);
    Params p{};
    for (int i = 0; i < 17; ++i) p.in[i] = (const float*)d_in[i];
    p.out = (float*)d_out; p.ws = (u8*)d_ws;
    void* args[] = {&p};
    hipError_t e = hipLaunchCooperativeKernel((const void*)mega_fwd, dim3(grid_blocks), dim3(512), args, LDS_BYTES, stream);
    if (e != hipSuccess) fprintf(stderr, "cooperative launch failed: %s (grid %d)\n", hipGetErrorString(e), grid_blocks);
}
```

```cpp
#include <hip/hip_runtime.h>
#include <hip/hip_cooperative_groups.h>
#include <cstdio>
namespace cg = cooperative_groups;

#define DI __device__ __forceinline__
#define LAS __attribute__((address_space(3)))
typedef unsigned short bf16_t;
typedef unsigned char u8;
typedef short bf16x8 __attribute__((ext_vector_type(8)));
typedef float f32x4 __attribute__((ext_vector_type(4)));
typedef unsigned u32x4 __attribute__((ext_vector_type(4)));
typedef unsigned u32x2 __attribute__((ext_vector_type(2)));

constexpr int DM = 2048, NB = 8, SEQ = 4096, CTXL = 256, DEPTH = 4;
constexpr int MLAT = NB * SEQ, MCTX = NB * CTXL, MTOT = MLAT + MCTX;
constexpr int DIN = 9232, PW = 9216, NGEMM = 9472;
constexpr float EPS = 1e-6f;
constexpr int PC_AU = 0, PC_AV = 512, PC_AZ = 1024, PC_BQ = 1536, PC_BK = 2560, PC_BV = 3584, PC_BO = 4608, PC_BZ = 5632,
              PC_CQ = 6656, PC_CFF = 7168, PC_CFB = 7680, PC_CI = 8192, PC_CG = 8704;
constexpr size_t WS_P = 0;
constexpr size_t WS_N = WS_P + (size_t)MTOT * PW * 2;
constexpr size_t WS_HCTX = WS_N + (size_t)MTOT * DM * 2;
constexpr size_t WS_WIN = WS_HCTX + (size_t)MCTX * DM * 4;
constexpr size_t WS_WOUT = WS_WIN + (size_t)NGEMM * DM * 2;
constexpr size_t WS_IM = WS_WOUT + (size_t)DM * DM * 2;
constexpr size_t WS_IH = WS_IM + (size_t)2 * MTOT * 1024 * 2;
constexpr size_t WS_GATES = WS_IH + (size_t)2 * MTOT * 512 * 2;
constexpr size_t WS_MOD = WS_GATES + (size_t)MTOT * 16 * 4;
constexpr size_t WS_LB = WS_MOD + (size_t)DEPTH * 9 * 6144 * 4;
constexpr size_t WS_MT = WS_LB + (size_t)DEPTH * 512 * 4;
constexpr size_t WS_DEN = WS_MT + (size_t)2 * MTOT * 4 * 4;
constexpr size_t WS_BAR = WS_DEN + (size_t)2 * MTOT * 4 * 4;
constexpr size_t WS_HALO = WS_BAR + 8192;
constexpr size_t WS_OI = WS_HALO + (size_t)272 * 2 * 2048 * 2;
constexpr size_t WS_QB = WS_OI + (size_t)MTOT * 512 * 2;
constexpr size_t WS_DEC = WS_QB + (size_t)MTOT * 512 * 2;
constexpr size_t WS_END = WS_DEC + (size_t)8 * 4 * 68 * 2 * 128 * 4;
constexpr int LDS_BYTES = 147456;

#ifndef DBG_SKIP_P3
#define DBG_SKIP_P3 0
#endif
#ifndef DBG_SKIP_P4
#define DBG_SKIP_P4 0
#endif
#ifndef DBG_NO_M
#define DBG_NO_M 0
#endif
#ifndef DBG_NO_H
#define DBG_NO_H 0
#endif
#ifndef DBG_NO_A
#define DBG_NO_A 0
#endif
#ifndef P2_WGM
#define P2_WGM 4
#endif
struct Params { const float* in[17]; float* out; u8* ws; };

typedef __bf16 bf16x2_t __attribute__((ext_vector_type(2)));
typedef float f32x2_t __attribute__((ext_vector_type(2)));
DI unsigned cvt_pk_bf16(float lo, float hi) { f32x2_t v = {lo, hi}; bf16x2_t b = __builtin_convertvector(v, bf16x2_t); return __builtin_bit_cast(unsigned, b); }
DI float bf_lo(unsigned u) { return __uint_as_float(u << 16); }
DI float bf_hi(unsigned u) { return __uint_as_float(u & 0xffff0000u); }
DI float rcpf_(float x) { return __builtin_amdgcn_rcpf(x); }
DI float sigmoidf_(float x) { return rcpf_(1.0f + __expf(-x)); }
DI float siluf_(float x) { return x * rcpf_(1.0f + __expf(-x)); }
DI float logsigf_(float x) { return fminf(x, 0.f) - __logf(1.0f + __expf(-fabsf(x))); }
DI void unpack8(const u32x4 r, float (&x)[8]) {
    x[0] = bf_lo(r.x); x[1] = bf_hi(r.x); x[2] = bf_lo(r.y); x[3] = bf_hi(r.y); x[4] = bf_lo(r.z); x[5] = bf_hi(r.z); x[6] = bf_lo(r.w); x[7] = bf_hi(r.w);
}
DI unsigned half_sel(unsigned u, int hi) { return hi ? (u >> 16) : (u & 0xffffu); }

template <int NT, int KS>
DI void mma_rows(const LAS u8* A, int lda, int m0, const LAS u8* Bm, int ldb, int n0, f32x4 (&acc)[NT], int fr, int fq) {
    const LAS u8* ap = A + (m0 + fr) * lda + fq * 16;
    const LAS u8* bp = Bm + (n0 + fr) * ldb + fq * 16;
#pragma unroll
    for (int ks = 0; ks < KS; ++ks) {
        const bf16x8 a = *(const LAS bf16x8*)(ap + ks * 64);
#pragma unroll
        for (int nt = 0; nt < NT; ++nt) {
            const bf16x8 b = *(const LAS bf16x8*)(bp + nt * 16 * ldb + ks * 64);
            acc[nt] = __builtin_amdgcn_mfma_f32_16x16x32_bf16(b, a, acc[nt], 0, 0, 0);
        }
    }
}

typedef short s16x4 __attribute__((ext_vector_type(4)));
DI bf16x8 ldfrag_tr(const LAS u8* T, int ld, int k0, int c0, int lane) {
    const int g = lane >> 4, q = (lane >> 2) & 3, p = lane & 3;
    const LAS u8* a = T + (k0 + 8 * g + q) * ld + (c0 + 4 * p) * 2;
    const s16x4 lo = __builtin_amdgcn_ds_read_tr16_b64_v4i16((LAS s16x4*)a);
    const s16x4 hi = __builtin_amdgcn_ds_read_tr16_b64_v4i16((LAS s16x4*)(a + 4 * ld));
    return __builtin_shufflevector(lo, hi, 0, 1, 2, 3, 4, 5, 6, 7);
}
template <int NT, int KS, bool TA, bool TB>
DI void mma_gen(const LAS u8* A, int lda, int m0, const LAS u8* Bm, int ldb, int n0, f32x4 (&acc)[NT], int lane) {
    const int fr = lane & 15, fq = lane >> 4;
#pragma unroll
    for (int ks = 0; ks < KS; ++ks) {
        bf16x8 a;
        if (TA) a = ldfrag_tr(A, lda, ks * 32, m0, lane); else a = *(const LAS bf16x8*)(A + (m0 + fr) * lda + fq * 16 + ks * 64);
#pragma unroll
        for (int nt = 0; nt < NT; ++nt) {
            bf16x8 b;
            if (TB) b = ldfrag_tr(Bm, ldb, ks * 32, n0 + nt * 16, lane); else b = *(const LAS bf16x8*)(Bm + (n0 + nt * 16 + fr) * ldb + fq * 16 + ks * 64);
            acc[nt] = __builtin_amdgcn_mfma_f32_16x16x32_bf16(b, a, acc[nt], 0, 0, 0);
        }
    }
}

template <int MT, int NT, int KS, bool TA, bool TB>
DI void mma_tile(const LAS u8* A, int lda, int m0, const LAS u8* Bm, int ldb, int n0, f32x4 (&acc)[MT][NT], int lane) {
    const int fr = lane & 15, fq = lane >> 4;
#pragma unroll 1
    for (int ks = 0; ks < KS; ++ks) {
        bf16x8 a[MT], b[NT];
#pragma unroll
        for (int mt = 0; mt < MT; ++mt) { if (TA) a[mt] = ldfrag_tr(A, lda, ks * 32, m0 + mt * 16, lane); else a[mt] = *(const LAS bf16x8*)(A + (m0 + mt * 16 + fr) * lda + fq * 16 + ks * 64); }
#pragma unroll
        for (int nt = 0; nt < NT; ++nt) { if (TB) b[nt] = ldfrag_tr(Bm, ldb, ks * 32, n0 + nt * 16, lane); else b[nt] = *(const LAS bf16x8*)(Bm + (n0 + nt * 16 + fr) * ldb + fq * 16 + ks * 64); }
#pragma unroll
        for (int mt = 0; mt < MT; ++mt)
#pragma unroll
            for (int nt = 0; nt < NT; ++nt) acc[mt][nt] = __builtin_amdgcn_mfma_f32_16x16x32_bf16(b[nt], a[mt], acc[mt][nt], 0, 0, 0);
    }
}

namespace pg8 {
constexpr int BM = 256, BK = 64, HALF = 128, HTB = HALF * BK * 2, STAGE_BYTES = 8 * HTB, NXCD = 8, WGM = 8;
DI int lds_byte(int r, int c) { const int st = (r >> 4) * 2 + (c >> 5), rr = r & 15, cc = c & 31, ob = rr * 64 + cc * 2; return st * 1024 + (ob ^ (((ob >> 9) & 1) << 5)); }
DI void stage_rc(int b, int& R, int& C) { const int st = b / 1024, sb = b % 1024, swz = sb ^ (((sb >> 9) & 1) << 5); R = (st >> 1) * 16 + swz / 64; C = (st & 1) * 32 + (swz % 64) / 2; }
DI int perm32(int rho) { const int n = rho >> 4, i = rho & 15; return 8 * (i >> 2) + 4 * n + (i & 3); }
struct Unit { int pm, pn; };
struct Gemm { const bf16_t* A; const bf16_t* Bt; int M, N, K; };
struct StaticOrder {
    int nM, nN, nwg, G, c, wgm;
    DI void init(int M, int N, int G_, int c_, int wgm_ = WGM) { nM = M / BM; nN = N / BM; nwg = nM * nN; G = G_; c = c_; wgm = wgm_; }
    DI bool next(int i, Unit& u) const {
        const long L = (long)i * G + c; if (L >= nwg) return false;
        int wgid = (int)L; { const int q = nwg / NXCD, r = nwg % NXCD, xcd = wgid % NXCD, off = wgid / NXCD; wgid = (xcd < r ? xcd * (q + 1) : r * (q + 1) + (xcd - r) * q) + off; }
        const int nig = wgm * nN, gid = wgid / nig, fm = gid * wgm, gsz = (nM - fm) < wgm ? (nM - fm) : wgm;
        u.pm = fm + ((wgid % nig) % gsz); u.pn = (wgid % nig) / gsz; return true;
    }
};

template <class Epi>
DI void gemm_phase(LAS u8* lds, const Gemm g, const StaticOrder& S, const Epi& E, const int tid) {
    const int wid = __builtin_amdgcn_readfirstlane(tid >> 6), lane = tid & 63, wr = wid >> 2, wc = wid & 3, fr = lane & 15, fq = lane >> 4;
    const int K = g.K, nt = K / BK;
    unsigned voffA[2], voffB[2];
#pragma unroll
    for (int i = 0; i < 2; ++i) { int R, C; stage_rc(tid * 16 + i * 8192, R, C); const int Rb = Epi::PERM ? ((R & ~31) + perm32(R & 31)) : R;
        voffA[i] = (unsigned)(R * K + C) * 2u; voffB[i] = (unsigned)(Rb * K + C) * 2u; }
    const size_t kstep = (size_t)(BK * 2);
    const size_t hstep = (size_t)HALF * K * 2;
    const size_t tstep = 2 * hstep;
    const unsigned ldsw = (unsigned)wid * 1024u;
    const int aoff = lds_byte(wr * 64 + fr, fq * 8), boff = lds_byte(wc * 32 + fr, fq * 8);
#define PG8_SA(b, h) (((b) * 2 + (h)) * HTB)
#define PG8_SB(b, h) ((4 + (b) * 2 + (h)) * HTB)
#define PG8_STAGE(bufoff, gbase, voff) do { _Pragma("unroll") for (int _i = 0; _i < 2; ++_i) \
        __builtin_amdgcn_global_load_lds((const unsigned*)((const char*)(gbase) + (voff)[_i]), (LAS unsigned*)(lds + (bufoff) + ldsw + _i * 8192), 16, 0, 0); } while (0)
#define PG8_LDA(dst, b, h) do { _Pragma("unroll") for (int m = 0; m < 4; ++m) _Pragma("unroll") for (int k = 0; k < 2; ++k) dst[m][k] = *(const LAS bf16x8*)(lds + PG8_SA(b, h) + aoff + m * 2048 + k * 1024); } while (0)
#define PG8_LDB(dst, b, h) do { _Pragma("unroll") for (int n = 0; n < 2; ++n) _Pragma("unroll") for (int k = 0; k < 2; ++k) dst[n][k] = *(const LAS bf16x8*)(lds + PG8_SB(b, h) + boff + n * 2048 + k * 1024); } while (0)
#define PG8_MMA(ai, bj, At, Bt) do { __builtin_amdgcn_s_setprio(1); _Pragma("unroll") for (int m = 0; m < 4; ++m) _Pragma("unroll") for (int n = 0; n < 2; ++n) _Pragma("unroll") for (int k = 0; k < 2; ++k) \
        acc[ai][bj][m][n] = __builtin_amdgcn_mfma_f32_16x16x32_bf16(Bt[n][k], At[m][k], acc[ai][bj][m][n], 0, 0, 0); __builtin_amdgcn_s_setprio(0); } while (0)
#define PG8_WAIT_V(n) asm volatile("s_waitcnt vmcnt(" #n ")" ::: "memory")
#define PG8_WAIT_L(n) asm volatile("s_waitcnt lgkmcnt(" #n ")" ::: "memory")
#define PG8_BAR __builtin_amdgcn_s_barrier()
#define PG8_SCHED __builtin_amdgcn_sched_barrier(0)
    Unit cur, nxt; int ui = 0;
    if (!S.next(0, cur)) return;
    f32x4 acc[2][2][4][2];
#pragma unroll
    for (int a = 0; a < 2; ++a)
#pragma unroll
        for (int b = 0; b < 2; ++b)
#pragma unroll
            for (int m = 0; m < 4; ++m)
#pragma unroll
                for (int n = 0; n < 2; ++n) acc[a][b][m][n] = (f32x4){0.f, 0.f, 0.f, 0.f};
    bf16x8 At[4][2], B0[2][2], B1[2][2];
    const char* cA = (const char*)g.A + (size_t)cur.pm * tstep; const char* cB = (const char*)g.Bt + (size_t)cur.pn * tstep;
    PG8_STAGE(PG8_SB(0, 0), cB, voffB); PG8_STAGE(PG8_SA(0, 0), cA, voffA); PG8_STAGE(PG8_SB(0, 1), cB + hstep, voffB); PG8_STAGE(PG8_SA(0, 1), cA + hstep, voffA);
    if (wr == 1) PG8_BAR;
    PG8_WAIT_V(4); PG8_BAR;
    PG8_STAGE(PG8_SB(1, 0), cB + kstep, voffB); PG8_STAGE(PG8_SA(1, 0), cA + kstep, voffA); PG8_STAGE(PG8_SB(1, 1), cB + hstep + kstep, voffB);
    PG8_WAIT_V(6); PG8_BAR;
    for (;;) {
        const bool has_next = S.next(ui + 1, nxt);
        const char* nA = has_next ? (const char*)g.A + (size_t)nxt.pm * tstep : cA; const char* nB = has_next ? (const char*)g.Bt + (size_t)nxt.pn * tstep : cB;
        for (int t = 0; t < nt; t += 2) {
            const bool last = (t == nt - 2);
            const char* a1 = cA + (size_t)(t + 1) * kstep;
            const char* a2 = last ? nA : cA + (size_t)(t + 2) * kstep; const char* b2 = last ? nB : cB + (size_t)(t + 2) * kstep;
            const char* a3 = a2 + kstep; const char* b3 = b2 + kstep;
            PG8_LDB(B0, 0, 0); PG8_SCHED; PG8_LDA(At, 0, 0); PG8_STAGE(PG8_SA(1, 1), a1 + hstep, voffA);
            PG8_WAIT_L(8); PG8_BAR; PG8_WAIT_L(0); PG8_MMA(0, 0, At, B0); PG8_BAR; PG8_SCHED;
            PG8_LDB(B1, 0, 1); PG8_STAGE(PG8_SB(0, 0), b2, voffB);
            PG8_BAR; PG8_WAIT_L(0); PG8_MMA(0, 1, At, B1); PG8_BAR;
            PG8_LDA(At, 0, 1); PG8_STAGE(PG8_SA(0, 0), a2, voffA);
            PG8_BAR; PG8_WAIT_L(0); PG8_MMA(1, 0, At, B0); PG8_BAR; PG8_SCHED;
            PG8_STAGE(PG8_SB(0, 1), b2 + hstep, voffB);
            PG8_WAIT_V(6); PG8_BAR; PG8_MMA(1, 1, At, B1); PG8_BAR;
            PG8_LDB(B0, 1, 0); PG8_SCHED; PG8_LDA(At, 1, 0); PG8_STAGE(PG8_SA(0, 1), a2 + hstep, voffA);
            PG8_WAIT_L(8); PG8_BAR; PG8_WAIT_L(0); PG8_MMA(0, 0, At, B0); PG8_BAR; PG8_SCHED;
            PG8_LDB(B1, 1, 1); PG8_STAGE(PG8_SB(1, 0), b3, voffB);
            PG8_BAR; PG8_WAIT_L(0); PG8_MMA(0, 1, At, B1); PG8_BAR;
            PG8_LDA(At, 1, 1); PG8_STAGE(PG8_SA(1, 0), a3, voffA);
            PG8_BAR; PG8_WAIT_L(0); PG8_MMA(1, 0, At, B0); PG8_BAR; PG8_SCHED;
            PG8_STAGE(PG8_SB(1, 1), b3 + hstep, voffB);
            PG8_WAIT_V(6); PG8_BAR; PG8_MMA(1, 1, At, B1); PG8_BAR;
        }
        E(acc, cur, wr, wc, fr, fq);
        if (!has_next) break;
#pragma unroll
        for (int a = 0; a < 2; ++a)
#pragma unroll
            for (int b = 0; b < 2; ++b)
#pragma unroll
                for (int m = 0; m < 4; ++m)
#pragma unroll
                    for (int n = 0; n < 2; ++n) acc[a][b][m][n] = (f32x4){0.f, 0.f, 0.f, 0.f};
        cur = nxt; cA = nA; cB = nB; ++ui;
    }
    PG8_WAIT_V(0);
    if (wr == 0) PG8_BAR;
    PG8_BAR;
#undef PG8_SA
#undef PG8_SB
#undef PG8_STAGE
#undef PG8_LDA
#undef PG8_LDB
#undef PG8_MMA
#undef PG8_WAIT_V
#undef PG8_WAIT_L
#undef PG8_BAR
#undef PG8_SCHED
}

struct EpiP {
    static constexpr bool PERM = true;
    bf16_t* Pb; float* gates; const float* bias; bf16_t* halo;
    DI void operator()(const f32x4 (&acc)[2][2][4][2], const Unit& u, int wr, int wc, int fr, int fq) const {
        const int row0 = u.pm * BM + wr * 64 + fr;
        if (u.pn < 36) {
            const int col0 = u.pn * BM + wc * 32 + 8 * fq;
            f32x4 bv[2][2];
#pragma unroll
            for (int bj = 0; bj < 2; ++bj) { const int c = col0 + bj * HALF; const int oc = c < 6656 ? c : c + 16;
                bv[bj][0] = *(const f32x4*)(bias + oc); bv[bj][1] = *(const f32x4*)(bias + oc + 4); }
#pragma unroll
            for (int ai = 0; ai < 2; ++ai)
#pragma unroll
                for (int m = 0; m < 4; ++m) { bf16_t* rowp = Pb + (size_t)(row0 + ai * HALF + m * 16) * PW + col0;
#pragma unroll
                    for (int bj = 0; bj < 2; ++bj) { const f32x4 v0 = acc[ai][bj][m][0] + bv[bj][0], v1 = acc[ai][bj][m][1] + bv[bj][1];
                        u32x4 w; w.x = cvt_pk_bf16(v0[0], v0[1]); w.y = cvt_pk_bf16(v0[2], v0[3]); w.z = cvt_pk_bf16(v1[0], v1[1]); w.w = cvt_pk_bf16(v1[2], v1[3]);
                        *(u32x4*)(rowp + bj * HALF) = w;
                        if (u.pn >= 6 && u.pn < 14) {
                            const int rr = wr * 64 + m * 16 + fr;
                            if (rr == 0 || rr == 127) *(u32x4*)(halo + ((size_t)((row0 + ai * HALF + m * 16) >> 7) * 2 + (rr ? 1 : 0)) * 2048 + (col0 - 1536) + bj * HALF) = w; } } }
        } else if (wc == 0 && fq < 2) {
            const f32x4 b0 = *(const f32x4*)(bias + 6656 + 8 * fq), b1 = *(const f32x4*)(bias + 6656 + 8 * fq + 4);
#pragma unroll
            for (int ai = 0; ai < 2; ++ai)
#pragma unroll
                for (int m = 0; m < 4; ++m) { float* gp = gates + (size_t)(row0 + ai * HALF + m * 16) * 16 + 8 * fq;
                    *(f32x4*)(gp) = acc[ai][0][m][0] + b0; *(f32x4*)(gp + 4) = acc[ai][0][m][1] + b1; }
        }
    }
};
struct EpiH {
    static constexpr bool PERM = true;
    const float* x_in; bf16_t* hb; bf16_t* hb_last; const float* hc_in; float* hc_out; const float* mod; int first, lastl;
    DI void operator()(const f32x4 (&acc)[2][2][4][2], const Unit& u, int wr, int wc, int fr, int fq) const {
        const int row0 = u.pm * BM + wr * 64 + fr, col0 = u.pn * BM + wc * 32 + 8 * fq;
        const bool lat = (u.pm * BM) < MLAT;
        const int b = lat ? ((u.pm * BM) >> 12) : 8;
        const float* gg = mod + b * 6144 + 4096 + col0;
        f32x4 gv[2][2];
#pragma unroll
        for (int bj = 0; bj < 2; ++bj)
#pragma unroll
            for (int n = 0; n < 2; ++n) gv[bj][n] = *(const f32x4*)(gg + bj * HALF + n * 4);
        if (lat && !first) {
#pragma unroll
            for (int ai = 0; ai < 2; ++ai) {
                u32x4 hv[4][2];
#pragma unroll
                for (int m = 0; m < 4; ++m) { const bf16_t* src = hb + (size_t)(row0 + ai * HALF + m * 16) * DM + col0;
#pragma unroll
                    for (int bj = 0; bj < 2; ++bj) hv[m][bj] = *(const u32x4*)(src + bj * HALF); }
#pragma unroll
                for (int m = 0; m < 4; ++m) { const size_t off = (size_t)(row0 + ai * HALF + m * 16) * DM + col0;
#pragma unroll
                    for (int bj = 0; bj < 2; ++bj) { float h8[8]; unpack8(hv[m][bj], h8);
                        const f32x4 o0 = (f32x4){h8[0], h8[1], h8[2], h8[3]} + gv[bj][0] * acc[ai][bj][m][0], o1 = (f32x4){h8[4], h8[5], h8[6], h8[7]} + gv[bj][1] * acc[ai][bj][m][1];
                        u32x4 w; w.x = cvt_pk_bf16(o0[0], o0[1]); w.y = cvt_pk_bf16(o0[2], o0[3]); w.z = cvt_pk_bf16(o1[0], o1[1]); w.w = cvt_pk_bf16(o1[2], o1[3]);
                        *(u32x4*)((lastl ? hb_last : hb) + off + bj * HALF) = w; } }
            }
        } else {
#pragma unroll
            for (int ai = 0; ai < 2; ++ai)
#pragma unroll
                for (int m = 0; m < 4; m += 2) {
                    f32x4 hv[2][2][2];
#pragma unroll
                    for (int m2 = 0; m2 < 2; ++m2) { const int row = row0 + ai * HALF + (m + m2) * 16;
                        const float* src = (lat ? x_in + (size_t)row * DM : hc_in + (size_t)(row - MLAT) * DM) + col0;
#pragma unroll
                        for (int bj = 0; bj < 2; ++bj)
#pragma unroll
                            for (int n = 0; n < 2; ++n) hv[m2][bj][n] = *(const f32x4*)(src + bj * HALF + n * 4); }
#pragma unroll
                    for (int m2 = 0; m2 < 2; ++m2) { const int row = row0 + ai * HALF + (m + m2) * 16;
#pragma unroll
                        for (int bj = 0; bj < 2; ++bj) { const f32x4 o0 = hv[m2][bj][0] + gv[bj][0] * acc[ai][bj][m + m2][0], o1 = hv[m2][bj][1] + gv[bj][1] * acc[ai][bj][m + m2][1];
                            if (!lat) { float* dst = hc_out + (size_t)(row - MLAT) * DM + col0 + bj * HALF; *(f32x4*)(dst) = o0; *(f32x4*)(dst + 4) = o1; }
                            else { u32x4 w; w.x = cvt_pk_bf16(o0[0], o0[1]); w.y = cvt_pk_bf16(o0[2], o0[3]); w.z = cvt_pk_bf16(o1[0], o1[1]); w.w = cvt_pk_bf16(o1[2], o1[3]); *(u32x4*)((lastl ? hb_last : hb) + (size_t)row * DM + col0 + bj * HALF) = w; } } }
                }
        }
    }
};
}

DI void phase0(const Params& P, LAS u8* lds, int tid) {
    LAS float* s = (LAS float*)lds;
    LAS float* red = (LAS float*)(lds + 73728);
    const float* c = P.in[1]; const float* cctx = P.in[3]; const float* w_ada = P.in[4]; const float* b_ada = P.in[5];
    float* mod = (float*)(P.ws + WS_MOD);
    for (int i = tid; i < 9 * 2048; i += 512) { const float v = i < 8 * 2048 ? c[i] : cctx[i - 8 * 2048]; s[i] = siluf_(v); }
    if (blockIdx.x == 0) {
        const float* lg = P.in[13]; float* lb = (float*)(P.ws + WS_LB);
        const float a0 = lg[tid], a1 = lg[512 + tid], a2 = lg[1024 + tid], a3 = lg[1536 + tid];
        const float mx = fmaxf(fmaxf(a0, a1), fmaxf(a2, a3));
        const float e0 = expf(a0 - mx), e1 = expf(a1 - mx), e2 = expf(a2 - mx), e3 = expf(a3 - mx);
        const float inv = 1.0f / (e0 + e1 + e2 + e3);
        const float p0 = e0 * inv, p1 = e1 * inv, p2 = e2 * inv, p3 = e3 * inv;
        lb[tid] = p0 - p0; lb[512 + tid] = (p0 + p1) - p0; lb[1024 + tid] = (p0 + p1 + p2) - p0; lb[1536 + tid] = (p0 + p1 + p2 + p3) - p0;
    }
    __syncthreads();
    const int w = tid >> 6, lane = tid & 63, cgp = lane & 15, kq = lane >> 4;
    for (int task = blockIdx.x; task < 384; task += gridDim.x) {
        const int l = task / 96, cb = task % 96;
        const float* W = w_ada + (size_t)l * 2048 * 6144 + cb * 64 + cgp * 4;
        f32x4 acc[9];
#pragma unroll
        for (int b = 0; b < 9; ++b) acc[b] = (f32x4){0.f, 0.f, 0.f, 0.f};
#pragma unroll 4
        for (int kk = 0; kk < 64; ++kk) {
            const int k = w * 256 + kk * 4 + kq;
            const f32x4 wv = __builtin_nontemporal_load((const f32x4*)(W + (size_t)k * 6144));
#pragma unroll
            for (int b = 0; b < 9; ++b) acc[b] += s[b * 2048 + k] * wv;
        }
#pragma unroll
        for (int b = 0; b < 9; ++b)
#pragma unroll
            for (int j = 0; j < 4; ++j) { float v = acc[b][j]; v += __shfl_xor(v, 16); v += __shfl_xor(v, 32); if (kq == 0) red[(w * 9 + b) * 64 + cgp * 4 + j] = v; }
        __syncthreads();
        for (int i = tid; i < 576; i += 512) { const int b = i >> 6, cc = i & 63; float v = b_ada[l * 6144 + cb * 64 + cc];
#pragma unroll
            for (int ww = 0; ww < 8; ++ww) v += red[(ww * 9 + b) * 64 + cc];
            mod[(size_t)(l * 9 + b) * 6144 + cb * 64 + cc] = v; }
        __syncthreads();
    }
}

DI void conv_tile256(const float* src, int ld, int nvalid, bf16_t* dst, LAS float* tile, int tid) {
    f32x4 v[8];
#pragma unroll
    for (int it = 0; it < 8; ++it) { const int idx = it * 512 + tid, k = idx >> 6, n = (idx & 63) * 4;
        v[it] = (f32x4){0.f, 0.f, 0.f, 0.f};
        if (n < nvalid) v[it] = __builtin_nontemporal_load((const f32x4*)(src + (size_t)k * ld + n)); }
#pragma unroll
    for (int it = 0; it < 8; ++it) { const int idx = it * 512 + tid, k = idx >> 6, n = (idx & 63) * 4;
        tile[k * 257 + n + 0] = v[it][0]; tile[k * 257 + n + 1] = v[it][1]; tile[k * 257 + n + 2] = v[it][2]; tile[k * 257 + n + 3] = v[it][3]; }
    __syncthreads();
    const int kg = tid & 7;
#pragma unroll
    for (int p = 0; p < 4; ++p) { const int nr = p * 64 + (tid >> 3);
        float x[8];
#pragma unroll
        for (int j = 0; j < 8; ++j) x[j] = tile[(kg * 8 + j) * 257 + nr];
        u32x4 w; w.x = cvt_pk_bf16(x[0], x[1]); w.y = cvt_pk_bf16(x[2], x[3]); w.z = cvt_pk_bf16(x[4], x[5]); w.w = cvt_pk_bf16(x[6], x[7]);
        *(u32x4*)(dst + (size_t)nr * DM + kg * 8) = w; }
    __syncthreads();
}

DI void phase1(const Params& P, int l, LAS u8* lds, int tid) {
    const float* hl = P.in[0]; const bf16_t* hb = (const bf16_t*)P.out; const float* hc = l == 0 ? P.in[2] : (const float*)(P.ws + WS_HCTX);
    const float* mod = (const float*)(P.ws + WS_MOD) + (size_t)l * 9 * 6144;
    const float* ng = P.in[6] + l * DM;
    bf16_t* N = (bf16_t*)(P.ws + WS_N);
    const int w = tid >> 6, lane = tid & 63;
    for (int grp = blockIdx.x; grp < MTOT / 32; grp += gridDim.x) {
        const int r0 = grp * 32 + w * 4;
        const int b = r0 < MLAT ? (r0 >> 12) : 8;
        const float* mb = mod + b * 6144;
        f32x4 gm[8], sh[8];
#pragma unroll
        for (int i = 0; i < 8; ++i) { const int c = (i * 64 + lane) * 4;
            const f32x4 g4 = *(const f32x4*)(ng + c), sc = *(const f32x4*)(mb + 2048 + c);
            gm[i] = g4 * (1.0f + sc); sh[i] = *(const f32x4*)(mb + c); }
#pragma unroll 1
        for (int r = 0; r < 4; ++r) { const int row = r0 + r;
            f32x4 x[8]; float ss = 0.f;
            if (row < MLAT && l > 0) {
                const bf16_t* srcb = hb + (size_t)row * DM;
#pragma unroll
                for (int i = 0; i < 8; ++i) { const u32x2 r2 = __builtin_nontemporal_load((const u32x2*)(srcb + (i * 64 + lane) * 4)); x[i] = (f32x4){bf_lo(r2.x), bf_hi(r2.x), bf_lo(r2.y), bf_hi(r2.y)}; }
            } else {
                const float* src = row < MLAT ? hl + (size_t)row * DM : hc + (size_t)(row - MLAT) * DM;
#pragma unroll
                for (int i = 0; i < 8; ++i) x[i] = __builtin_nontemporal_load((const f32x4*)(src + (i * 64 + lane) * 4));
            }
#pragma unroll
            for (int i = 0; i < 8; ++i) ss += x[i][0] * x[i][0] + x[i][1] * x[i][1] + x[i][2] * x[i][2] + x[i][3] * x[i][3];
#pragma unroll
            for (int o = 32; o >= 1; o >>= 1) ss += __shfl_xor(ss, o);
            const float rstd = rsqrtf(ss * (1.0f / DM) + EPS);
            bf16_t* dst = N + (size_t)row * DM;
#pragma unroll
            for (int i = 0; i < 8; ++i) { const f32x4 y = x[i] * rstd * gm[i] + sh[i];
                u32x2 pk; pk.x = cvt_pk_bf16(y[0], y[1]); pk.y = cvt_pk_bf16(y[2], y[3]);
                *(u32x2*)(dst + (i * 64 + lane) * 4) = pk; } }
    }
    LAS float* tile = (LAS float*)lds;
    const float* win = P.in[7] + (size_t)l * DM * DIN; const float* wout = P.in[15] + (size_t)l * DM * DM;
    bf16_t* WinT = (bf16_t*)(P.ws + WS_WIN); bf16_t* WoutT = (bf16_t*)(P.ws + WS_WOUT);
    constexpr int NT_IN = (NGEMM / 256) * 32, NT_OUT = 8 * 32;
    for (int t = blockIdx.x; t < NT_IN + NT_OUT; t += gridDim.x) {
        if (t < NT_IN) { const int nt = t >> 5, kt = t & 31; const int np = nt * 256;
            int nsrc, nvalid;
            if (np < 6656) { nsrc = np; nvalid = 256; } else if (np < 9216) { nsrc = np + 16; nvalid = 256; } else { nsrc = 6656; nvalid = 16; }
            conv_tile256(win + (size_t)(kt * 64) * DIN + nsrc, DIN, nvalid, WinT + (size_t)np * DM + kt * 64, tile, tid);
        } else { const int tt = t - NT_IN; const int nt = tt >> 5, kt = tt & 31;
            conv_tile256(wout + (size_t)(kt * 64) * DM + nt * 256, DM, 256, WoutT + (size_t)(nt * 256) * DM + kt * 64, tile, tid); }
    }
}

DI void task_chunkmlp(const Params& P, int l, int cidx, int g, LAS u8* lds, int tid) {
    LAS u8* wsA = lds; LAS u8* vnT = lds + 34816;
    const bf16_t* Pb = (const bf16_t*)(P.ws + WS_P); bf16_t* mix = (bf16_t*)(P.ws + WS_N);
    const int w = tid >> 6, lane = tid & 63, fr = lane & 15, fq = lane >> 4;
    const int R0 = cidx * 128;
    const float* Ws = P.in[9] + (size_t)(l * 4 + g) * 16384;
#pragma unroll
    for (int i = 0; i < 8; ++i) { const int idx = i * 512 + tid, t = idx >> 5, s4 = (idx & 31) * 4;
        const f32x4 v = *(const f32x4*)(Ws + t * 128 + s4);
        u32x2 pk; pk.x = cvt_pk_bf16(v[0], v[1]); pk.y = cvt_pk_bf16(v[2], v[3]);
        *(LAS u32x2*)(wsA + t * 272 + s4 * 2) = pk; }
    {
        const int s = tid >> 2, qd = tid & 3;
        const bf16_t* vp = Pb + (size_t)(R0 + s) * PW + PC_AV + g * 128 + qd * 32;
        float x[32];
#pragma unroll
        for (int i = 0; i < 4; ++i) { const u32x4 r = *(const u32x4*)(vp + i * 8); float t8[8]; unpack8(r, t8);
#pragma unroll
            for (int j = 0; j < 8; ++j) x[i * 8 + j] = t8[j]; }
        float sm = 0.f;
#pragma unroll
        for (int i = 0; i < 32; ++i) sm += x[i];
        sm += __shfl_xor(sm, 1); sm += __shfl_xor(sm, 2);
        const float mu = sm * (1.0f / 128.0f);
        float vq = 0.f;
#pragma unroll
        for (int i = 0; i < 32; ++i) { x[i] -= mu; vq += x[i] * x[i]; }
        vq += __shfl_xor(vq, 1); vq += __shfl_xor(vq, 2);
        const float rs = rsqrtf(vq * (1.0f / 128.0f) + EPS);
#pragma unroll
        for (int i = 0; i < 32; i += 2) { const unsigned pk = cvt_pk_bf16(x[i] * rs, x[i + 1] * rs);
            *(LAS bf16_t*)(vnT + (qd * 32 + 16 * ((i >> 2) & 1) + 4 * (i >> 3) + (i & 3)) * 272 + s * 2) = (bf16_t)(pk & 0xffffu);
            *(LAS bf16_t*)(vnT + (qd * 32 + 16 * (((i + 1) >> 2) & 1) + 4 * ((i + 1) >> 3) + ((i + 1) & 3)) * 272 + s * 2) = (bf16_t)(pk >> 16); }
    }
    __syncthreads();
    f32x4 acc[8];
#pragma unroll
    for (int i = 0; i < 8; ++i) acc[i] = (f32x4){0.f, 0.f, 0.f, 0.f};
    mma_rows<8, 4>(wsA, 272, 16 * w, vnT, 272, 0, acc, fr, fq);
    const int t = 16 * w + fr; const size_t R = (size_t)(R0 + t);
    const float bs = P.in[10][(l * 4 + g) * 128 + t];
#pragma unroll
    for (int gp = 0; gp < 4; ++gp) { const int c = g * 128 + gp * 32 + 8 * fq;
        const u32x4 ur = *(const u32x4*)(Pb + R * PW + PC_AU + c), zr = *(const u32x4*)(Pb + R * PW + PC_AZ + c);
        float uf[8], zf[8]; unpack8(ur, uf); unpack8(zr, zf);
        float y[8];
#pragma unroll
        for (int j = 0; j < 4; ++j) { y[j] = uf[j] * (acc[2 * gp][j] + bs) * siluf_(zf[j]); y[4 + j] = uf[4 + j] * (acc[2 * gp + 1][j] + bs) * siluf_(zf[4 + j]); }
        u32x4 pk; pk.x = cvt_pk_bf16(y[0], y[1]); pk.y = cvt_pk_bf16(y[2], y[3]); pk.z = cvt_pk_bf16(y[4], y[5]); pk.w = cvt_pk_bf16(y[6], y[7]);
        *(u32x4*)(mix + R * DM + c) = pk; }
    __syncthreads();
}

DI void task_conv(const Params& P, int l, int chunk, int isk, int h, int tid) {
    bf16_t* Pb = (bf16_t*)(P.ws + WS_P); const bf16_t* halo = (const bf16_t*)(P.ws + WS_HALO);
    const int cg = tid & 31, rg = tid >> 5; const int d0 = cg * 8, t0 = rg * 8;
    const int R0 = chunk * 128;
    const bool has_prev = (chunk < 256) ? ((chunk & 31) != 0) : ((chunk & 1) != 0);
    const bool has_next = (chunk < 256) ? ((chunk & 31) != 31) : ((chunk & 1) != 1);
    const float* cw = P.in[11] + (size_t)l * 3 * 2048 + isk * 1024 + h * 256;
    const float scale = isk ? 0.0625f : 1.0f;
    const int hc = isk * 1024 + h * 256 + d0;
    bf16_t* base = Pb + (size_t)(R0 + t0) * PW + PC_BQ + hc;
    u32x4 raw[10];
#pragma unroll
    for (int r = 1; r < 9; ++r) raw[r] = *(const u32x4*)(base + (ptrdiff_t)(r - 1) * PW);
    raw[0] = (u32x4){0u, 0u, 0u, 0u}; raw[9] = raw[0];
    if (t0 > 0) raw[0] = *(const u32x4*)(base - (ptrdiff_t)PW);
    else if (has_prev) raw[0] = *(const u32x4*)(halo + ((size_t)(chunk - 1) * 2 + 1) * 2048 + hc);
    if (t0 < 120) raw[9] = *(const u32x4*)(base + (ptrdiff_t)8 * PW);
    else if (has_next) raw[9] = *(const u32x4*)(halo + ((size_t)(chunk + 1) * 2 + 0) * 2048 + hc);
    float w0[8], w1[8], w2[8];
#pragma unroll
    for (int hh = 0; hh < 2; ++hh) { const f32x4 a = *(const f32x4*)(cw + d0 + 4 * hh), b = *(const f32x4*)(cw + 2048 + d0 + 4 * hh), c = *(const f32x4*)(cw + 4096 + d0 + 4 * hh);
#pragma unroll
        for (int j = 0; j < 4; ++j) { w0[4 * hh + j] = a[j]; w1[4 * hh + j] = b[j]; w2[4 * hh + j] = c[j]; } }
    asm volatile("s_waitcnt vmcnt(0)" ::: "memory");
    __syncthreads();
    float xp[8], xc[8], xn[8];
    unpack8(raw[0], xp); unpack8(raw[1], xc);
#pragma unroll
    for (int r = 0; r < 8; ++r) {
        unpack8(raw[r + 2], xn);
        float y[8];
#pragma unroll
        for (int c = 0; c < 8; ++c) { const float v = w0[c] * xp[c] + w1[c] * xc[c] + w2[c] * xn[c]; y[c] = siluf_(v) * scale; }
        u32x4 o; o.x = cvt_pk_bf16(y[0], y[1]); o.y = cvt_pk_bf16(y[2], y[3]); o.z = cvt_pk_bf16(y[4], y[5]); o.w = cvt_pk_bf16(y[6], y[7]);
        *(u32x4*)(base + (ptrdiff_t)r * PW) = o;
#pragma unroll
        for (int c = 0; c < 8; ++c) { xp[c] = xc[c]; xc[c] = xn[c]; }
    }
}

template <bool TR>
DI void stage_plain(const bf16_t* Pb, int R0, int col0, LAS u8* dst, int tid) {
    const int cg = tid & 31, rg = tid >> 5; const int d0 = cg * 8, t0 = rg * 8;
    const bf16_t* base = Pb + (size_t)(R0 + t0) * PW + col0 + d0;
    u32x4 raw[8];
#pragma unroll
    for (int r = 0; r < 8; ++r) raw[r] = *(const u32x4*)(base + (size_t)r * PW);
    if (!TR) {
#pragma unroll
        for (int r = 0; r < 8; ++r) *(LAS u32x4*)(dst + (t0 + r) * 528 + d0 * 2) = raw[r];
    } else {
#pragma unroll
        for (int c = 0; c < 8; ++c) { u32x4 v; const int cw = c >> 1, hi = c & 1;
            v.x = half_sel(raw[0][cw], hi) | (half_sel(raw[1][cw], hi) << 16); v.y = half_sel(raw[2][cw], hi) | (half_sel(raw[3][cw], hi) << 16);
            v.z = half_sel(raw[4][cw], hi) | (half_sel(raw[5][cw], hi) << 16); v.w = half_sel(raw[6][cw], hi) | (half_sel(raw[7][cw], hi) << 16);
            *(LAS u32x4*)(dst + (d0 + c) * 272 + t0 * 2) = v; }
    }
}

struct GateScan { int t0, t1; float cb0, cb1, gi0, gi1; };
DI GateScan gate_scan(const float* G, int R0, int dir, int h, int lane) {
    GateScan r;
    const int p0 = 2 * lane, p1 = p0 + 1;
    r.t0 = dir ? 127 - p0 : p0; r.t1 = dir ? 127 - p1 : p1;
    const float* g0 = G + (size_t)(R0 + r.t0) * 16 + dir * 8 + h; const float* g1 = G + (size_t)(R0 + r.t1) * 16 + dir * 8 + h;
    r.gi0 = g0[0]; r.gi1 = g1[0];
    const float x0 = logsigf_(g0[4]), x1 = logsigf_(g1[4]);
    float s = x0 + x1;
#pragma unroll
    for (int o = 1; o < 64; o <<= 1) { const float v = __shfl_up(s, o); if (lane >= o) s += v; }
    r.cb1 = s; r.cb0 = s - x1;
    return r;
}

DI void task_m1(const Params& P, int l, int task, LAS u8* lds, const int tid0) {
    const int b = task >> 4, h = (task >> 2) & 3, dir = (task >> 1) & 1, sl = task & 1;
    LAS u8* QN = lds;
    LAS u8* CB = lds + 67584;
    LAS u8* WS16 = lds + 102400;
    LAS u8* NB = lds + 135168;
    LAS float* einter = (LAS float*)(lds + 143616); LAS float* wsv = einter + 128; LAS float* scal = wsv + 128;
    const bf16_t* Pb = (const bf16_t*)(P.ws + WS_P); const float* G = (const float*)(P.ws + WS_GATES);
    bf16_t* IM = (bf16_t*)(P.ws + WS_IM); float* MT = (float*)(P.ws + WS_MT); float* DEN = (float*)(P.ws + WS_DEN);
    f32x4 Cst[4][4]; f32x4 nacc[1][2];
#pragma unroll
    for (int i = 0; i < 4; ++i)
#pragma unroll
        for (int j = 0; j < 4; ++j) Cst[i][j] = (f32x4){0.f, 0.f, 0.f, 0.f};
    nacc[0][0] = (f32x4){0.f, 0.f, 0.f, 0.f}; nacc[0][1] = nacc[0][0];
    float m_prev = 0.f;
    u32x4 rq[8], rk[8], rv[4];
#define M1_R0(n_) (((n_) < 2) ? (MLAT + b * CTXL + (dir ? 1 - (n_) : (n_)) * 128) : (b * SEQ + (dir ? 31 - ((n_) - 2) : (n_) - 2) * 128))
    {
        const int R0 = M1_R0(0);
        const bf16_t* base = Pb + (size_t)(R0 + (tid0 >> 5) * 8) * PW + PC_BQ + h * 256 + (tid0 & 31) * 8;
#pragma unroll
        for (int r = 0; r < 8; ++r) rq[r] = *(const u32x4*)(base + (size_t)r * PW);
    }
    for (int i = tid0; i < 16 * 528 / 4; i += 512) ((LAS unsigned*)NB)[i] = 0u;
    __syncthreads();
#pragma unroll 1
    for (int n = 0; n < 34; ++n) {
        int tid = tid0; asm volatile("" : "+v"(tid));
        const int w = tid >> 6, lane = tid & 63, fr = lane & 15, fq = lane >> 4, wm = w >> 2, wn = w & 3;
        const int cg = tid & 31, rg = tid >> 5, cg16 = tid & 15, rg32 = tid >> 4;
        const int R0 = M1_R0(n);
#pragma unroll
        for (int r = 0; r < 8; ++r) *(LAS u32x4*)(QN + (rg * 8 + r) * 528 + cg * 16) = rq[r];
        __builtin_amdgcn_sched_barrier(0);
#pragma unroll
        for (int mt = 0; mt < 4; ++mt)
#pragma unroll
            for (int nt = 0; nt < 4; ++nt) { u32x2 pk; pk.x = cvt_pk_bf16(Cst[mt][nt][0], Cst[mt][nt][1]); pk.y = cvt_pk_bf16(Cst[mt][nt][2], Cst[mt][nt][3]);
                *(LAS u32x2*)(CB + (64 * wm + 32 * (mt >> 1) + 16 * ((fr >> 2) & 1) + 4 * (2 * (mt & 1) + (fr >> 3)) + (fr & 3)) * 528 + (64 * wn + nt * 16 + 4 * fq) * 2) = pk; }
        if (fr == 0) {
#pragma unroll
            for (int nt = 0; nt < 2; ++nt) { u32x2 pk; pk.x = cvt_pk_bf16(nacc[0][nt][0], nacc[0][nt][1]); pk.y = cvt_pk_bf16(nacc[0][nt][2], nacc[0][nt][3]);
                *(LAS u32x2*)(NB + (32 * w + nt * 16 + 4 * fq) * 2) = pk; }
        }
        if (w == 0) {
            const GateScan gs = gate_scan(G, R0, dir, h, lane);
            const float y0 = gs.gi0 - gs.cb0, y1 = gs.gi1 - gs.cb1;
            float incl = fmaxf(y0, y1);
#pragma unroll
            for (int o = 1; o < 64; o <<= 1) { const float v = __shfl_up(incl, o); if (lane >= o) incl = fmaxf(incl, v); }
            float excl = __shfl_up(incl, 1); if (lane == 0) excl = -3.0e38f;
            const float a0 = fmaxf(excl, y0), a1 = incl;
            const float mt0 = gs.cb0 + fmaxf(m_prev, a0), mt1 = gs.cb1 + fmaxf(m_prev, a1);
            const float cl = __shfl(gs.cb1, 63), amax = __shfl(a1, 63);
            const float m_new = cl + fmaxf(m_prev, amax);
            einter[gs.t0] = __expf(gs.cb0 + m_prev - mt0); einter[gs.t1] = __expf(gs.cb1 + m_prev - mt1);
            wsv[gs.t0] = __expf(cl - gs.cb0 + gs.gi0 - m_new); wsv[gs.t1] = __expf(cl - gs.cb1 + gs.gi1 - m_new);
            if (lane == 0) scal[0] = __expf(cl + m_prev - m_new);
            if (sl == 0) { MT[((size_t)dir * MTOT + R0 + gs.t0) * 4 + h] = mt0; MT[((size_t)dir * MTOT + R0 + gs.t1) * 4 + h] = mt1; }
            m_prev = m_new;
        }
        {
            const bf16_t* kb = Pb + (size_t)(R0 + rg * 8) * PW + PC_BK + h * 256 + cg * 8;
#pragma unroll
            for (int r = 0; r < 8; ++r) rk[r] = *(const u32x4*)(kb + (size_t)r * PW);
            const bf16_t* vb = Pb + (size_t)(R0 + rg32 * 4) * PW + PC_BV + h * 256 + sl * 128 + cg16 * 8;
#pragma unroll
            for (int r = 0; r < 4; ++r) rv[r] = *(const u32x4*)(vb + (size_t)r * PW);
        }
        __syncthreads();
        {
            f32x4 o[4][2];
#pragma unroll
            for (int i = 0; i < 4; ++i) { o[i][0] = (f32x4){0.f, 0.f, 0.f, 0.f}; o[i][1] = o[i][0]; }
            mma_tile<4, 2, 8, false, false>(QN, 528, 64 * wm, CB, 528, 32 * wn, o, lane);
            f32x4 on[1][1]; on[0][0] = (f32x4){0.f, 0.f, 0.f, 0.f};
            mma_tile<1, 1, 8, false, false>(QN, 528, 16 * w, NB, 528, 0, on, lane);
#pragma unroll
            for (int mt = 0; mt < 4; ++mt) { const int t = 64 * wm + mt * 16 + fr; const float ei = einter[t];
                bf16_t* dstp = IM + ((size_t)dir * MTOT + R0 + t) * 1024 + h * 256 + sl * 128 + 32 * wn + 8 * fq;
                u32x4 pk; pk.x = cvt_pk_bf16(o[mt][0][0] * ei, o[mt][0][1] * ei); pk.y = cvt_pk_bf16(o[mt][0][2] * ei, o[mt][0][3] * ei);
                pk.z = cvt_pk_bf16(o[mt][1][0] * ei, o[mt][1][1] * ei); pk.w = cvt_pk_bf16(o[mt][1][2] * ei, o[mt][1][3] * ei);
                *(u32x4*)(dstp) = pk; }
            if (sl == 0 && fq == 0) { const int t = 16 * w + fr; DEN[((size_t)dir * MTOT + R0 + t) * 4 + h] = einter[t] * on[0][0][0]; }
        }
        __syncthreads();
#pragma unroll
        for (int r = 0; r < 8; ++r) *(LAS u32x4*)(QN + (rg * 8 + r) * 528 + cg * 16) = rk[r];
#pragma unroll
        for (int r = 0; r < 4; ++r) { float v8[8]; unpack8(rv[r], v8); const float wv = wsv[rg32 * 4 + r];
            u32x4 ov; ov.x = cvt_pk_bf16(v8[0] * wv, v8[1] * wv); ov.y = cvt_pk_bf16(v8[2] * wv, v8[3] * wv); ov.z = cvt_pk_bf16(v8[4] * wv, v8[5] * wv); ov.w = cvt_pk_bf16(v8[6] * wv, v8[7] * wv);
            *(LAS u32x4*)(CB + (rg32 * 4 + r) * 272 + cg16 * 16) = ov; }
        if (tid < 128) { const unsigned wbits = cvt_pk_bf16(wsv[tid], 0.f);
            *(LAS u32x4*)(WS16 + tid * 48) = (u32x4){wbits, 0u, 0u, 0u}; *(LAS u32x4*)(WS16 + tid * 48 + 16) = (u32x4){0u, 0u, 0u, 0u}; }
        __syncthreads();
        {
            const float ec = scal[0];
#pragma unroll
            for (int i = 0; i < 4; ++i)
#pragma unroll
                for (int j = 0; j < 4; ++j) Cst[i][j] *= ec;
            nacc[0][0] *= ec; nacc[0][1] *= ec;
            mma_tile<4, 4, 4, true, true>(CB, 272, 64 * wm, QN, 528, 64 * wn, Cst, lane);
            mma_tile<1, 2, 4, true, true>(WS16, 48, 0, QN, 528, 32 * w, nacc, lane);
        }
        if (n + 1 < 34) {
            const int R1 = M1_R0(n + 1);
            const bf16_t* qb = Pb + (size_t)(R1 + rg * 8) * PW + PC_BQ + h * 256 + cg * 8;
#pragma unroll
            for (int r = 0; r < 8; ++r) rq[r] = *(const u32x4*)(qb + (size_t)r * PW);
        }
        __syncthreads();
    }
#undef M1_R0
}

DI void task_m2(const Params& P, int l, int b, int h, int cpos, LAS u8* lds, int tid) {
    LAS u8* R1 = lds; LAS u8* R2 = lds + 69632; LAS float* sm = (LAS float*)(lds + 139264);
    const bf16_t* Pb = (const bf16_t*)(P.ws + WS_P); const float* G = (const float*)(P.ws + WS_GATES); bf16_t* mix = (bf16_t*)(P.ws + WS_N);
    const bf16_t* IM = (const bf16_t*)(P.ws + WS_IM); const float* MT = (const float*)(P.ws + WS_MT); const float* DEN = (const float*)(P.ws + WS_DEN);
    const int w = tid >> 6, lane = tid & 63, fr = lane & 15, fq = lane >> 4;
    const int R0 = (cpos < 2) ? (MLAT + b * CTXL + cpos * 128) : (b * SEQ + (cpos - 2) * 128);
    if (w < 2) {
        const int dir = w; const GateScan gs = gate_scan(G, R0, dir, h, lane);
        LAS float* q = sm + dir * 512;
        q[gs.t0] = gs.cb0; q[gs.t1] = gs.cb1; q[128 + gs.t0] = gs.gi0 - gs.cb0; q[128 + gs.t1] = gs.gi1 - gs.cb1;
        q[256 + gs.t0] = MT[((size_t)dir * MTOT + R0 + gs.t0) * 4 + h]; q[256 + gs.t1] = MT[((size_t)dir * MTOT + R0 + gs.t1) * 4 + h];
        q[384 + gs.t0] = DEN[((size_t)dir * MTOT + R0 + gs.t0) * 4 + h]; q[384 + gs.t1] = DEN[((size_t)dir * MTOT + R0 + gs.t1) * 4 + h];
    }
    stage_plain<false>(Pb, R0, PC_BQ + h * 256, R1, tid);
    stage_plain<false>(Pb, R0, PC_BK + h * 256, R2, tid);
    __syncthreads();
    const int t = 16 * w + fr;
    float rNf, rNb;
    unsigned pp[8][2];
    {
        f32x4 s[8];
#pragma unroll
        for (int i = 0; i < 8; ++i) s[i] = (f32x4){0.f, 0.f, 0.f, 0.f};
        mma_rows<8, 8>(R1, 528, 16 * w, R2, 528, 0, s, fr, fq);
        const float cbf_t = sm[t], mtf_t = sm[256 + t], dnf_t = sm[384 + t], cbb_t = sm[512 + t], mtb_t = sm[768 + t], dnb_t = sm[896 + t];
        float vf[8][4], vb[8][4]; float sumf = 0.f, sumb = 0.f;
#pragma unroll
        for (int nt = 0; nt < 8; ++nt) { const f32x4 bif = *(const LAS f32x4*)(sm + 128 + nt * 16 + 4 * fq), bib = *(const LAS f32x4*)(sm + 640 + nt * 16 + 4 * fq);
#pragma unroll
            for (int j = 0; j < 4; ++j) { const int si = nt * 16 + 4 * fq + j;
                const float wf = __uint_as_float(__float_as_uint(__expf(cbf_t + bif[j] - mtf_t)) & ~(unsigned)((t - si) >> 31));
                const float wb = __uint_as_float(__float_as_uint(__expf(cbb_t + bib[j] - mtb_t)) & ~(unsigned)((si - t) >> 31));
                vf[nt][j] = s[nt][j] * wf; vb[nt][j] = s[nt][j] * wb; sumf += vf[nt][j]; sumb += vb[nt][j]; } }
        sumf += __shfl_xor(sumf, 16); sumf += __shfl_xor(sumf, 32); sumb += __shfl_xor(sumb, 16); sumb += __shfl_xor(sumb, 32);
        rNf = rcpf_(fmaxf(fabsf(sumf + dnf_t), __expf(-mtf_t))); rNb = rcpf_(fmaxf(fabsf(sumb + dnb_t), __expf(-mtb_t)));
#pragma unroll
        for (int nt = 0; nt < 8; ++nt) { pp[nt][0] = cvt_pk_bf16(vf[nt][0] * rNf + vb[nt][0] * rNb, vf[nt][1] * rNf + vb[nt][1] * rNb);
            pp[nt][1] = cvt_pk_bf16(vf[nt][2] * rNf + vb[nt][2] * rNb, vf[nt][3] * rNf + vb[nt][3] * rNb); }
    }
    __syncthreads();
#pragma unroll
    for (int nt = 0; nt < 8; ++nt) { u32x2 pk; pk.x = pp[nt][0]; pk.y = pp[nt][1]; *(LAS u32x2*)(R1 + t * 272 + (nt * 16 + 4 * fq) * 2) = pk; }
    {
        const int cg = tid & 31, rg = tid >> 5;
        const bf16_t* vp = Pb + (size_t)(R0 + rg * 8) * PW + PC_BV + h * 256 + cg * 8;
        u32x4 raw[8];
#pragma unroll
        for (int r = 0; r < 8; ++r) raw[r] = *(const u32x4*)(vp + (size_t)r * PW);
#pragma unroll
        for (int c = 0; c < 8; ++c) { u32x4 v; const int cw = c >> 1, hi = c & 1;
            v.x = half_sel(raw[0][cw], hi) | (half_sel(raw[1][cw], hi) << 16); v.y = half_sel(raw[2][cw], hi) | (half_sel(raw[3][cw], hi) << 16);
            v.z = half_sel(raw[4][cw], hi) | (half_sel(raw[5][cw], hi) << 16); v.w = half_sel(raw[6][cw], hi) | (half_sel(raw[7][cw], hi) << 16);
            *(LAS u32x4*)(R2 + (32 * (cg >> 2) + 16 * ((c >> 2) & 1) + 4 * (cg & 3) + (c & 3)) * 272 + (rg * 8) * 2) = v; }
    }
    __syncthreads();
    {
        f32x4 o[16];
#pragma unroll
        for (int i = 0; i < 16; ++i) o[i] = (f32x4){0.f, 0.f, 0.f, 0.f};
        mma_rows<16, 4>(R1, 272, 16 * w, R2, 272, 0, o, fr, fq);
        const size_t R = (size_t)(R0 + t);
        const bf16_t* imf = IM + R * 1024 + h * 256; const bf16_t* imb = IM + ((size_t)MTOT + R) * 1024 + h * 256;
        float ssq = 0.f;
#pragma unroll
        for (int gp = 0; gp < 8; ++gp) { const int e = gp * 32 + 8 * fq;
            const u32x4 a = *(const u32x4*)(imf + e), c = *(const u32x4*)(imb + e);
            float af[8], cf[8]; unpack8(a, af); unpack8(c, cf);
#pragma unroll
            for (int j = 0; j < 4; ++j) { o[2 * gp][j] += af[j] * rNf + cf[j] * rNb; o[2 * gp + 1][j] += af[4 + j] * rNf + cf[4 + j] * rNb;
                ssq += o[2 * gp][j] * o[2 * gp][j] + o[2 * gp + 1][j] * o[2 * gp + 1][j]; } }
        ssq += __shfl_xor(ssq, 16); ssq += __shfl_xor(ssq, 32);
        const float rstd = rsqrtf(ssq * (1.0f / 256.0f) + EPS);
        const float* mg = P.in[12] + l * 1024 + h * 256;
#pragma unroll
        for (int gp = 0; gp < 8; ++gp) { const int e = gp * 32 + 8 * fq;
            const f32x4 g0 = *(const f32x4*)(mg + e), g1 = *(const f32x4*)(mg + e + 4);
            const u32x4 bo = *(const u32x4*)(Pb + R * PW + PC_BO + h * 256 + e), bz = *(const u32x4*)(Pb + R * PW + PC_BZ + h * 256 + e);
            float bof[8], bzf[8]; unpack8(bo, bof); unpack8(bz, bzf);
            float y[8];
#pragma unroll
            for (int j = 0; j < 4; ++j) { y[j] = o[2 * gp][j] * rstd * g0[j] * sigmoidf_(bof[j]) * siluf_(bzf[j]); y[4 + j] = o[2 * gp + 1][j] * rstd * g1[j] * sigmoidf_(bof[4 + j]) * siluf_(bzf[4 + j]); }
            u32x4 pk; pk.x = cvt_pk_bf16(y[0], y[1]); pk.y = cvt_pk_bf16(y[2], y[3]); pk.z = cvt_pk_bf16(y[4], y[5]); pk.w = cvt_pk_bf16(y[6], y[7]);
            *(u32x4*)(mix + R * DM + 512 + h * 256 + e) = pk; }
    }
    __syncthreads();
}

DI void hgrn_gate16(const u32x4 z0, const u32x4 z1, const float (&lbv)[16], float (&kk)[16], LAS float* lfrow) {
    float z[16]; { float a[8], b[8]; unpack8(z0, a); unpack8(z1, b);
#pragma unroll
        for (int j = 0; j < 8; ++j) { z[j] = a[j]; z[8 + j] = b[j]; } }
    float lf[16];
#pragma unroll
    for (int j = 0; j < 16; ++j) { const float f = fmaxf(lbv[j] + (1.0f - lbv[j]) * sigmoidf_(z[j]), 1e-30f); lf[j] = __logf(f); kk[j] = 1.0f - f; }
#pragma unroll
    for (int j = 0; j < 4; ++j) *(LAS f32x4*)(lfrow + 4 * j) = (f32x4){lf[4 * j], lf[4 * j + 1], lf[4 * j + 2], lf[4 * j + 3]};
}

DI void task_hpre(const Params& P, int l, int b, int hd, int cpos, LAS u8* lds, int tid) {
    LAS float* lf = (LAS float*)lds; LAS u8* qd = lds + 32768; LAS u8* kd = lds + 50176; LAS u8* vN = lds + 67584; LAS u8* Pm = lds + 84992; LAS float* tot = (LAS float*)(lds + 94208);
    bf16_t* Pb = (bf16_t*)(P.ws + WS_P); bf16_t* OI = (bf16_t*)(P.ws + WS_OI); bf16_t* QB = (bf16_t*)(P.ws + WS_QB);
    float* DEC = (float*)(P.ws + WS_DEC) + (size_t)(((b * 4 + hd) * 68 + cpos) * 2) * 128;
    const float* lb = (const float*)(P.ws + WS_LB) + l * 512 + hd * 128;
    const int w = tid >> 6, lane = tid & 63, fr = lane & 15, fq = lane >> 4;
    const int i = tid >> 3, cg = tid & 7, c0 = cg * 16;
    int rbase, rstride;
    if (cpos < 4) { rbase = MLAT + b * CTXL + cpos * 64; rstride = 1; } else { rbase = b * SEQ + (cpos - 4); rstride = 64; }
    float lbv[16];
#pragma unroll
    for (int j = 0; j < 16; ++j) lbv[j] = lb[c0 + j];
    bf16_t* prow = Pb + (size_t)(rbase + i * rstride) * PW + hd * 128 + c0;
    float q[16];
    { const u32x4 q0 = *(const u32x4*)(prow + PC_CQ), q1 = *(const u32x4*)(prow + PC_CQ + 8); float a[8], c[8]; unpack8(q0, a); unpack8(q1, c);
#pragma unroll
        for (int j = 0; j < 8; ++j) { q[j] = siluf_(a[j]); q[8 + j] = siluf_(c[j]); } }
    { const u32x4 v0 = *(const u32x4*)(prow + PC_CI), v1 = *(const u32x4*)(prow + PC_CI + 8);
        *(LAS u32x4*)(vN + i * 272 + c0 * 2) = v0; *(LAS u32x4*)(vN + i * 272 + c0 * 2 + 16) = v1; }
    const u32x4 zf0 = *(const u32x4*)(prow + PC_CFF), zf1 = *(const u32x4*)(prow + PC_CFF + 8);
    const u32x4 zb0 = *(const u32x4*)(prow + PC_CFB), zb1 = *(const u32x4*)(prow + PC_CFB + 8);
    f32x4 sc[2]; sc[0] = (f32x4){0.f, 0.f, 0.f, 0.f}; sc[1] = sc[0];
    const int ii = 16 * (w >> 1) + fr;
#pragma unroll 1
    for (int d = 0; d < 2; ++d) {
        float kk[16];
        hgrn_gate16(d ? zb0 : zf0, d ? zb1 : zf1, lbv, kk, lf + i * 128 + c0);
        __syncthreads();
        {
            const int c = tid & 127, part = tid >> 7;
            float x[16];
#pragma unroll
            for (int k = 0; k < 16; ++k) { const int sidx = part * 16 + k; const int i2 = d ? 63 - sidx : sidx; x[k] = lf[i2 * 128 + c]; }
#pragma unroll
            for (int k = 1; k < 16; ++k) x[k] += x[k - 1];
            tot[part * 128 + c] = x[15];
            __syncthreads();
            float off = 0.f;
#pragma unroll
            for (int pp = 0; pp < 3; ++pp) off += (pp < part) ? tot[pp * 128 + c] : 0.f;
#pragma unroll
            for (int k = 0; k < 16; ++k) { const int sidx = part * 16 + k; const int i2 = d ? 63 - sidx : sidx; lf[i2 * 128 + c] = x[k] + off; }
            if (part == 3) DEC[d * 128 + c] = __expf(x[15] + off);
        }
        __syncthreads();
        {
            const int ilast = d ? 0 : 63;
            unsigned qo[8], ko[8], qs[8], ks[8];
#pragma unroll
            for (int j = 0; j < 16; j += 2) {
                const float cb0 = lf[i * 128 + c0 + j], cb1 = lf[i * 128 + c0 + j + 1], rf0 = lf[32 * 128 + c0 + j], rf1 = lf[32 * 128 + c0 + j + 1];
                const float cl0 = lf[ilast * 128 + c0 + j], cl1 = lf[ilast * 128 + c0 + j + 1];
                qo[j >> 1] = cvt_pk_bf16(q[j] * __expf(cb0 - rf0), q[j + 1] * __expf(cb1 - rf1));
                ko[j >> 1] = cvt_pk_bf16(kk[j] * __expf(rf0 - cb0), kk[j + 1] * __expf(rf1 - cb1));
                qs[j >> 1] = cvt_pk_bf16(q[j] * __expf(cb0), q[j + 1] * __expf(cb1));
                ks[j >> 1] = cvt_pk_bf16(kk[j] * __expf(cl0 - cb0), kk[j + 1] * __expf(cl1 - cb1)); }
            *(LAS u32x4*)(qd + i * 272 + c0 * 2) = (u32x4){qo[0], qo[1], qo[2], qo[3]}; *(LAS u32x4*)(qd + i * 272 + c0 * 2 + 16) = (u32x4){qo[4], qo[5], qo[6], qo[7]};
            *(LAS u32x4*)(kd + i * 272 + c0 * 2) = (u32x4){ko[0], ko[1], ko[2], ko[3]}; *(LAS u32x4*)(kd + i * 272 + c0 * 2 + 16) = (u32x4){ko[4], ko[5], ko[6], ko[7]};
            bf16_t* qdst = d ? QB + (size_t)(rbase + i * rstride) * 512 + hd * 128 + c0 : prow + PC_CQ;
            bf16_t* kdst = prow + (d ? PC_CFB : PC_CFF);
            *(u32x4*)(qdst) = (u32x4){qs[0], qs[1], qs[2], qs[3]}; *(u32x4*)(qdst + 8) = (u32x4){qs[4], qs[5], qs[6], qs[7]};
            *(u32x4*)(kdst) = (u32x4){ks[0], ks[1], ks[2], ks[3]}; *(u32x4*)(kdst + 8) = (u32x4){ks[4], ks[5], ks[6], ks[7]};
        }
        __syncthreads();
        {
            f32x4 s2[2]; s2[0] = (f32x4){0.f, 0.f, 0.f, 0.f}; s2[1] = s2[0];
            mma_rows<2, 4>(qd, 272, 16 * (w >> 1), kd, 272, 32 * (w & 1), s2, fr, fq);
#pragma unroll
            for (int nt = 0; nt < 2; ++nt)
#pragma unroll
                for (int j = 0; j < 4; ++j) { const int jj = 32 * (w & 1) + nt * 16 + 4 * fq + j; const int df = d ? (jj - ii) : (ii - jj); sc[nt][j] += __uint_as_float(__float_as_uint(s2[nt][j]) & ~(unsigned)(df >> 31)); }
        }
        __syncthreads();
    }
#pragma unroll
    for (int nt = 0; nt < 2; ++nt) { u32x2 pk; pk.x = cvt_pk_bf16(sc[nt][0], sc[nt][1]); pk.y = cvt_pk_bf16(sc[nt][2], sc[nt][3]);
        *(LAS u32x2*)(Pm + ii * 144 + (32 * (w & 1) + nt * 16 + 4 * fq) * 2) = pk; }
    __syncthreads();
    {
        f32x4 o[4];
#pragma unroll
        for (int j = 0; j < 4; ++j) o[j] = (f32x4){0.f, 0.f, 0.f, 0.f};
        mma_gen<4, 2, false, true>(Pm, 144, 16 * (w & 3), vN, 272, 64 * (w >> 2), o, lane);
        const int io = 16 * (w & 3) + fr; const size_t Ro = (size_t)(rbase + io * rstride);
        bf16_t* dstp = OI + Ro * 512 + hd * 128 + 64 * (w >> 2);
#pragma unroll
        for (int nt = 0; nt < 4; ++nt) { u32x2 pk; pk.x = cvt_pk_bf16(o[nt][0], o[nt][1]); pk.y = cvt_pk_bf16(o[nt][2], o[nt][3]); *(u32x2*)(dstp + nt * 16 + 4 * fq) = pk; }
    }
    __syncthreads();
}

DI void task_h1(const Params& P, int l, int task, LAS u8* lds, const int tid0) {
    const int b = task >> 3, hd = (task >> 1) & 3, dir = task & 1;
    LAS u8* qh = lds; LAS u8* kh = lds + 17408; LAS u8* vN = lds + 34816; LAS u8* SB = lds + 52224;
    const bf16_t* Pb = (const bf16_t*)(P.ws + WS_P); const bf16_t* QB = (const bf16_t*)(P.ws + WS_QB); bf16_t* IH = (bf16_t*)(P.ws + WS_IH);
    const float* DECb = (const float*)(P.ws + WS_DEC) + (size_t)((b * 4 + hd) * 68) * 256 + dir * 128;
    f32x4 st[8];
#pragma unroll
    for (int j = 0; j < 8; ++j) st[j] = (f32x4){0.f, 0.f, 0.f, 0.f};
    u32x4 rq0, rq1, rk0, rk1, rv0, rv1; f32x4 dc[8];
#define H1_LOAD(n_) do { const int n__ = (n_); int rb_, rs_, cp_; \
        if (n__ < 4) { const int cc = dir ? 3 - n__ : n__; rb_ = MLAT + b * CTXL + cc * 64; rs_ = 1; cp_ = cc; } \
        else { const int wc = dir ? 63 - (n__ - 4) : n__ - 4; rb_ = b * SEQ + wc; rs_ = 64; cp_ = 4 + wc; } \
        const int i_ = tid0 >> 3, c0_ = (tid0 & 7) * 16; const size_t R_ = (size_t)(rb_ + i_ * rs_); \
        const bf16_t* pr_ = Pb + R_ * PW + hd * 128 + c0_; \
        const bf16_t* qp_ = dir ? QB + R_ * 512 + hd * 128 + c0_ : pr_ + PC_CQ; \
        rq0 = *(const u32x4*)(qp_); rq1 = *(const u32x4*)(qp_ + 8); \
        rk0 = *(const u32x4*)(pr_ + (dir ? PC_CFB : PC_CFF)); rk1 = *(const u32x4*)(pr_ + (dir ? PC_CFB : PC_CFF) + 8); \
        rv0 = *(const u32x4*)(pr_ + PC_CI); rv1 = *(const u32x4*)(pr_ + PC_CI + 8); \
        const int fq_ = (tid0 & 63) >> 4; \
        _Pragma("unroll") for (int nt = 0; nt < 8; ++nt) dc[nt] = *(const f32x4*)(DECb + (size_t)cp_ * 256 + nt * 16 + 4 * fq_); } while (0)
    H1_LOAD(0);
#pragma unroll 1
    for (int n = 0; n < 68; ++n) {
        int tid = tid0; asm volatile("" : "+v"(tid));
        const int w = tid >> 6, lane = tid & 63, fr = lane & 15, fq = lane >> 4;
        const int i = tid >> 3, c0 = (tid & 7) * 16;
        int rbase, rstride;
        if (n < 4) { const int cc = dir ? 3 - n : n; rbase = MLAT + b * CTXL + cc * 64; rstride = 1; }
        else { const int wc = dir ? 63 - (n - 4) : n - 4; rbase = b * SEQ + wc; rstride = 64; }
        *(LAS u32x4*)(qh + i * 272 + c0 * 2) = rq0; *(LAS u32x4*)(qh + i * 272 + c0 * 2 + 16) = rq1;
        *(LAS u32x4*)(kh + i * 272 + c0 * 2) = rk0; *(LAS u32x4*)(kh + i * 272 + c0 * 2 + 16) = rk1;
        *(LAS u32x4*)(vN + i * 272 + c0 * 2) = rv0; *(LAS u32x4*)(vN + i * 272 + c0 * 2 + 16) = rv1;
        {
            const int e = 32 * (w >> 1) + 16 * ((fr >> 2) & 1) + 4 * (2 * (w & 1) + (fr >> 3)) + (fr & 3);
#pragma unroll
            for (int nt = 0; nt < 8; ++nt) { u32x2 pk; pk.x = cvt_pk_bf16(st[nt][0], st[nt][1]); pk.y = cvt_pk_bf16(st[nt][2], st[nt][3]);
                *(LAS u32x2*)(SB + e * 272 + (nt * 16 + 4 * fq) * 2) = pk; }
        }
        f32x4 dcur[8];
#pragma unroll
        for (int nt = 0; nt < 8; ++nt) dcur[nt] = dc[nt];
        if (n + 1 < 68) H1_LOAD(n + 1);
        __syncthreads();
        {
            f32x4 o[4];
#pragma unroll
            for (int j = 0; j < 4; ++j) o[j] = (f32x4){0.f, 0.f, 0.f, 0.f};
            mma_rows<4, 4>(qh, 272, 16 * (w & 3), SB, 272, 64 * (w >> 2), o, fr, fq);
            const int io = 16 * (w & 3) + fr;
            bf16_t* dstp = IH + ((size_t)dir * MTOT + rbase + io * rstride) * 512 + hd * 128 + 64 * (w >> 2);
#pragma unroll
            for (int gp = 0; gp < 2; ++gp) { u32x4 pk; pk.x = cvt_pk_bf16(o[2 * gp][0], o[2 * gp][1]); pk.y = cvt_pk_bf16(o[2 * gp][2], o[2 * gp][3]);
                pk.z = cvt_pk_bf16(o[2 * gp + 1][0], o[2 * gp + 1][1]); pk.w = cvt_pk_bf16(o[2 * gp + 1][2], o[2 * gp + 1][3]); *(u32x4*)(dstp + gp * 32 + 8 * fq) = pk; }
#pragma unroll
            for (int nt = 0; nt < 8; ++nt) st[nt] *= dcur[nt];
            mma_gen<8, 2, true, true>(vN, 272, 16 * w, kh, 272, 0, st, lane);
        }
        __syncthreads();
    }
#undef H1_LOAD
}

DI void phase_hpost(const Params& P, int l, int nrows, int tid, int bfirst, int nblk) {
    const bf16_t* Pb = (const bf16_t*)(P.ws + WS_P); const bf16_t* IH = (const bf16_t*)(P.ws + WS_IH); const bf16_t* OI = (const bf16_t*)(P.ws + WS_OI);
    bf16_t* mix = (bf16_t*)(P.ws + WS_N);
    const int w = tid >> 6, lane = tid & 63;
    const float* hg = P.in[14] + l * 512 + lane * 8;
    const f32x4 g0 = *(const f32x4*)(hg), g1 = *(const f32x4*)(hg + 4);
    if ((int)blockIdx.x < bfirst) return;
    for (int R = ((int)blockIdx.x - bfirst) * 8 + w; R < nrows; R += nblk * 8) {
        const u32x4 a = __builtin_nontemporal_load((const u32x4*)(OI + (size_t)R * 512 + lane * 8)), f = __builtin_nontemporal_load((const u32x4*)(IH + (size_t)R * 512 + lane * 8)), bb = __builtin_nontemporal_load((const u32x4*)(IH + ((size_t)MTOT + R) * 512 + lane * 8));
        const u32x4 gz = __builtin_nontemporal_load((const u32x4*)(Pb + (size_t)R * PW + PC_CG + lane * 8));
        float x[8], y[8], z[8], gg[8]; unpack8(a, x); unpack8(f, y); unpack8(bb, z); unpack8(gz, gg);
        float ssq = 0.f;
#pragma unroll
        for (int j = 0; j < 8; ++j) { x[j] += y[j] + z[j]; ssq += x[j] * x[j]; }
        ssq += __shfl_xor(ssq, 1); ssq += __shfl_xor(ssq, 2); ssq += __shfl_xor(ssq, 4); ssq += __shfl_xor(ssq, 8);
        const float rstd = rsqrtf(ssq * (1.0f / 128.0f) + EPS);
        u32x4 o;
        o.x = cvt_pk_bf16(x[0] * rstd * g0[0] * siluf_(gg[0]), x[1] * rstd * g0[1] * siluf_(gg[1]));
        o.y = cvt_pk_bf16(x[2] * rstd * g0[2] * siluf_(gg[2]), x[3] * rstd * g0[3] * siluf_(gg[3]));
        o.z = cvt_pk_bf16(x[4] * rstd * g1[0] * siluf_(gg[4]), x[5] * rstd * g1[1] * siluf_(gg[5]));
        o.w = cvt_pk_bf16(x[6] * rstd * g1[2] * siluf_(gg[6]), x[7] * rstd * g1[3] * siluf_(gg[7]));
        *(u32x4*)(mix + (size_t)R * DM + 1536 + lane * 8) = o;
    }
}

DI void phase_final(const Params& P, int tid) {
    const float* fg = P.in[16]; float* out = P.out; const bf16_t* hf = (const bf16_t*)(P.ws + WS_P);
    const int w = tid >> 6, lane = tid & 63;
    f32x4 g[8];
#pragma unroll
    for (int i = 0; i < 8; ++i) g[i] = *(const f32x4*)(fg + (i * 64 + lane) * 4);
    for (int row = blockIdx.x * 8 + w; row < MLAT; row += gridDim.x * 8) {
        float* p = out + (size_t)row * DM; const bf16_t* ph = hf + (size_t)row * DM;
        f32x4 x[8]; float ss = 0.f;
#pragma unroll
        for (int i = 0; i < 8; ++i) { const u32x2 r2 = __builtin_nontemporal_load((const u32x2*)(ph + (i * 64 + lane) * 4)); x[i] = (f32x4){bf_lo(r2.x), bf_hi(r2.x), bf_lo(r2.y), bf_hi(r2.y)}; ss += x[i][0] * x[i][0] + x[i][1] * x[i][1] + x[i][2] * x[i][2] + x[i][3] * x[i][3]; }
#pragma unroll
        for (int o = 32; o >= 1; o >>= 1) ss += __shfl_xor(ss, o);
        const float rstd = rsqrtf(ss * (1.0f / DM) + EPS);
#pragma unroll
        for (int i = 0; i < 8; ++i) *(f32x4*)(p + (i * 64 + lane) * 4) = x[i] * rstd * g[i];
    }
}

DI void grid_bar(unsigned* cnt, unsigned target) {
    asm volatile("s_waitcnt vmcnt(0) lgkmcnt(0)" ::: "memory");
    __syncthreads();
    if (threadIdx.x < 64) {
        __builtin_amdgcn_fence(__ATOMIC_RELEASE, "agent");
        if (threadIdx.x == 0) {
            __hip_atomic_fetch_add(cnt, 1u, __ATOMIC_RELAXED, __HIP_MEMORY_SCOPE_AGENT);
            while (__hip_atomic_load(cnt, __ATOMIC_RELAXED, __HIP_MEMORY_SCOPE_AGENT) < target) __builtin_amdgcn_s_sleep(1);
        }
        __builtin_amdgcn_fence(__ATOMIC_ACQUIRE, "agent");
        asm volatile("s_waitcnt vmcnt(0)" ::: "memory");
    }
    __syncthreads();
}
DI unsigned xcc_id() { return (unsigned)__builtin_amdgcn_s_getreg((3 << 11) | 20) & 0xFu; }
DI void xcd_bar(unsigned* bar, unsigned nb, unsigned xcc, unsigned xcnt, unsigned nxcc) {
    asm volatile("s_waitcnt vmcnt(0) lgkmcnt(0)" ::: "memory");
    __syncthreads();
    if (threadIdx.x < 64) {
        if (threadIdx.x == 0) {
            const unsigned old = __hip_atomic_fetch_add(bar + 640 + 64 * xcc, 1u, __ATOMIC_RELAXED, __HIP_MEMORY_SCOPE_AGENT);
            if (old + 1u == nb * xcnt) {
                __builtin_amdgcn_fence(__ATOMIC_RELEASE, "agent");
                asm volatile("s_waitcnt vmcnt(0)" ::: "memory");
                __hip_atomic_fetch_add(bar + 1216, 1u, __ATOMIC_RELAXED, __HIP_MEMORY_SCOPE_AGENT);
            }
            unsigned spins = 0;
            while (__hip_atomic_load(bar + 1216, __ATOMIC_RELAXED, __HIP_MEMORY_SCOPE_AGENT) < nb * nxcc && ++spins < (1u << 22)) __builtin_amdgcn_s_sleep(1);
        }
        __builtin_amdgcn_fence(__ATOMIC_ACQUIRE, "agent");
        asm volatile("s_waitcnt vmcnt(0)" ::: "memory");
    }
    __syncthreads();
}
typedef const __attribute__((address_space(4))) Params* KargP;
#if defined(__HIP_DEVICE_COMPILE__)
DI Params fresh_params() { KargP pp = (KargP)__builtin_amdgcn_kernarg_segment_ptr(); asm volatile("" : "+s"(pp)); Params r;
#pragma unroll
    for (int i = 0; i < 17; ++i) r.in[i] = pp->in[i];
    r.out = pp->out; r.ws = pp->ws; return r; }
#else
DI Params fresh_params() { return Params{}; }
#endif

__global__ void __launch_bounds__(512, 2) mega_fwd(Params Pk) {
    extern __shared__ __attribute__((aligned(16))) u8 lds_raw[];
    LAS u8* lds = (LAS u8*)lds_raw;
    cg::grid_group grid = cg::this_grid();
    const int G = gridDim.x;
    unsigned nbar = 0;
    grid.sync();
    unsigned my_xcc, my_xcnt, n_xcc;
    {
        const Params Pb_ = fresh_params(); unsigned* bar = (unsigned*)(Pb_.ws + WS_BAR);
        my_xcc = __builtin_amdgcn_readfirstlane(xcc_id()) & 7u;
        if (threadIdx.x == 0) __hip_atomic_fetch_add(bar + 64 + 64 * my_xcc, 1u, __ATOMIC_RELAXED, __HIP_MEMORY_SCOPE_AGENT);
        grid_bar(bar, (unsigned)G);
        my_xcnt = __hip_atomic_load(bar + 64 + 64 * my_xcc, __ATOMIC_RELAXED, __HIP_MEMORY_SCOPE_AGENT);
        n_xcc = 0;
        for (int j = 0; j < 8; ++j) n_xcc += (__hip_atomic_load(bar + 64 + 64 * j, __ATOMIC_RELAXED, __HIP_MEMORY_SCOPE_AGENT) != 0u) ? 1u : 0u;
    }
#define GRID_SYNC() do { const Params Pb_ = fresh_params(); ++nbar; xcd_bar((unsigned*)(Pb_.ws + WS_BAR), nbar, my_xcc, my_xcnt, n_xcc); } while (0)
#define FRESH_TID int tid = threadIdx.x; asm volatile("" : "+v"(tid))

    { FRESH_TID; const Params P = fresh_params(); phase0(P, lds, tid); }
    GRID_SYNC();
#pragma unroll 1
    for (int l = 0; l < DEPTH; ++l) {
        const bool last = (l == DEPTH - 1);
        { FRESH_TID; const Params P = fresh_params(); phase1(P, l, lds, tid); }
        GRID_SYNC();
        {
            FRESH_TID; const Params P = fresh_params();
            pg8::Gemm g{(const bf16_t*)(P.ws + WS_N), (const bf16_t*)(P.ws + WS_WIN), MTOT, NGEMM, DM};
            pg8::StaticOrder S; S.init(MTOT, NGEMM, G, (int)blockIdx.x, P2_WGM);
            pg8::EpiP E{(bf16_t*)(P.ws + WS_P), (float*)(P.ws + WS_GATES), P.in[8] + (size_t)l * DIN, (bf16_t*)(P.ws + WS_HALO)};
            pg8::gemm_phase<pg8::EpiP>(lds, g, S, E, tid);
        }
        GRID_SYNC();
        {
            FRESH_TID; const Params P = fresh_params();
            const int n_pre = (G == 256) ? 1472 : 2176;
            for (int task = blockIdx.x; task < n_pre + 272 * 8; task += G) {
                int tl = tid; asm volatile("" : "+v"(tl));
                if (task < n_pre) task_hpre(P, l, task / 272, (task / 68) & 3, task % 68, lds, tl);
                else { const int a = task - n_pre; task_conv(P, l, a >> 3, (a >> 2) & 1, a & 3, tl); }
            }
        }
        GRID_SYNC();
        {
            FRESH_TID; const Params P = fresh_params();
            const int nA = last ? 1024 : 1088;
            const int bx = blockIdx.x;
            if (G == 256) {
                if (bx < 128) { int tl = tid; asm volatile("" : "+v"(tl)); task_m1(P, l, bx, lds, tl); }
                else {
                    const int hb = bx - 128;
                    {
                        const int t_first = (hb < 64) ? 1472 + hb : 1472 + 256 + (hb - 64), t_cnt = (hb < 64) ? 4 : 7;
                        for (int k = 0; k < t_cnt; ++k) { const int t2 = t_first + 64 * k; int tl = tid; asm volatile("" : "+v"(tl)); task_hpre(P, l, t2 / 272, (t2 / 68) & 3, t2 % 68, lds, tl); }
                    }
                    grid_bar((unsigned*)(P.ws + WS_BAR + 6144), (unsigned)(l + 1) * 128u);
                    if (hb < 64) { int tl = tid; asm volatile("" : "+v"(tl)); task_h1(P, l, hb, lds, tl); }
                    else { for (int a = hb - 64; a < nA; a += 64) { int tl = tid; asm volatile("" : "+v"(tl)); task_chunkmlp(P, l, a >> 2, a & 3, lds, tl); } }
                }
            }
            else if (bx < 128 && G >= 192) { int tl = tid; asm volatile("" : "+v"(tl)); task_m1(P, l, bx, lds, tl); }
            else {
                if (G < 192) { for (int t2 = bx; t2 < 128; t2 += G) { int tl = tid; asm volatile("" : "+v"(tl)); task_m1(P, l, t2, lds, tl); } }
                const int hb = (G >= 192) ? bx - 128 : bx, hs = (G >= 192) ? G - 128 : G;
                for (int t2 = hb; t2 < 64; t2 += hs) { int tl = tid; asm volatile("" : "+v"(tl)); task_h1(P, l, t2, lds, tl); }
                for (int a = hb; a < nA; a += hs) { int tl = tid; asm volatile("" : "+v"(tl)); task_chunkmlp(P, l, a >> 2, a & 3, lds, tl); }
            }
        }
        GRID_SYNC();
        {
            FRESH_TID; const Params P = fresh_params();
            const int nM2 = last ? 1024 : 1088;
            for (int task = blockIdx.x; task < nM2; task += G) {
                int tl = tid; asm volatile("" : "+v"(tl));
                int b, h, cpos;
                if (last) { cpos = 2 + (task & 31); h = (task >> 5) & 3; b = task >> 7; } else { cpos = task % 34; h = (task / 34) & 3; b = task / 136; }
                task_m2(P, l, b, h, cpos, lds, tl);
            }
            {
                const int nfull = nM2 % G; const int bfirst = (nfull > 0 && nfull < G) ? nfull : 0;
                phase_hpost(P, l, last ? MLAT : MTOT, tid, bfirst, G - bfirst);
            }
        }
        GRID_SYNC();
        {
            FRESH_TID; const Params P = fresh_params();
            const int M = last ? MLAT : MTOT;
            pg8::Gemm g{(const bf16_t*)(P.ws + WS_N), (const bf16_t*)(P.ws + WS_WOUT), M, DM, DM};
            pg8::StaticOrder S; S.init(M, DM, G, (int)blockIdx.x, 4);
            pg8::EpiH E{P.in[0], (bf16_t*)P.out, (bf16_t*)(P.ws + WS_P), l == 0 ? P.in[2] : (const float*)(P.ws + WS_HCTX), (float*)(P.ws + WS_HCTX),
                        (const float*)(P.ws + WS_MOD) + (size_t)l * 9 * 6144, l == 0 ? 1 : 0, last ? 1 : 0};
            pg8::gemm_phase<pg8::EpiH>(lds, g, S, E, tid);
        }
        GRID_SYNC();
    }
    { FRESH_TID; const Params P = fresh_params(); phase_final(P, tid); }
}

extern "C" void kernel_launch(void* const* d_in, const int* in_sizes, int n_in, void* d_out, int out_size, void* d_ws, size_t ws_size, hipStream_t stream) {
    static int grid_blocks = 0;
    if (grid_blocks == 0) {
        if (ws_size < WS_END) { fprintf(stderr, "kernel_launch: workspace too small: %zu < %zu\n", ws_size, (size_t)WS_END); grid_blocks = -1; return; }
        int dev = 0, cus = 0, per_cu = 0;
        (void)hipGetDevice(&dev);
        (void)hipDeviceGetAttribute(&cus, hipDeviceAttributeMultiprocessorCount, dev);
        if (hipFuncSetAttribute((const void*)mega_fwd, hipFuncAttributeMaxDynamicSharedMemorySize, LDS_BYTES) != hipSuccess) { fprintf(stderr, "kernel_launch: hipFuncSetAttribute failed\n"); grid_blocks = -1; return; }
        if (hipOccupancyMaxActiveBlocksPerMultiprocessor(&per_cu, (const void*)mega_fwd, 512, LDS_BYTES) != hipSuccess || per_cu < 1) { fprintf(stderr, "kernel_launch: occupancy query says %d\n", per_cu); per_cu = 1; }
        (void)hipGetLastError();
        grid_blocks = cus * per_cu;
    }
    if (grid_blocks < 0) return;
    (void)hipMemsetAsync((u8*)d_ws + WS_BAR, 0, 8192, stream);
    Params p{};
    for (int i = 0; i < 17; ++i) p.in[i] = (const float*)d_in[i];
    p.out = (float*)d_out; p.ws = (u8*)d_ws;
    void* args[] = {&p};
    hipError_t e = hipLaunchCooperativeKernel((const void*)mega_fwd, dim3(grid_blocks), dim3(512), args, LDS_BYTES, stream);
    if (e != hipSuccess) fprintf(stderr, "cooperative launch failed: %s (grid %d)\n", hipGetErrorString(e), grid_blocks);
}
```

```cpp
#include <hip/hip_runtime.h>
#include <hip/hip_cooperative_groups.h>
#include <cstdio>
namespace cg = cooperative_groups;

#define DI __device__ __forceinline__
#define LAS __attribute__((address_space(3)))
typedef unsigned short bf16_t;
typedef unsigned char u8;
typedef short bf16x8 __attribute__((ext_vector_type(8)));
typedef float f32x4 __attribute__((ext_vector_type(4)));
typedef unsigned u32x4 __attribute__((ext_vector_type(4)));
typedef unsigned u32x2 __attribute__((ext_vector_type(2)));

constexpr int DM = 2048, NB = 8, SEQ = 4096, CTXL = 256, DEPTH = 4;
constexpr int MLAT = NB * SEQ, MCTX = NB * CTXL, MTOT = MLAT + MCTX;
constexpr int DIN = 9232, PW = 9216, NGEMM = 9472;
constexpr float EPS = 1e-6f;
constexpr int PC_AU = 0, PC_AV = 512, PC_AZ = 1024, PC_BQ = 1536, PC_BK = 2560, PC_BV = 3584, PC_BO = 4608, PC_BZ = 5632,
              PC_CQ = 6656, PC_CFF = 7168, PC_CFB = 7680, PC_CI = 8192, PC_CG = 8704;
constexpr size_t WS_P = 0;
constexpr size_t WS_N = WS_P + (size_t)MTOT * PW * 2;
constexpr size_t WS_HCTX = WS_N + (size_t)MTOT * DM * 2;
constexpr size_t WS_WIN = WS_HCTX + (size_t)MCTX * DM * 4;
constexpr size_t WS_WOUT = WS_WIN + (size_t)NGEMM * DM * 2;
constexpr size_t WS_IM = WS_WOUT + (size_t)DM * DM * 2;
constexpr size_t WS_IH = WS_IM + (size_t)2 * MTOT * 1024 * 2;
constexpr size_t WS_GATES = WS_IH + (size_t)2 * MTOT * 512 * 2;
constexpr size_t WS_MOD = WS_GATES + (size_t)MTOT * 16 * 4;
constexpr size_t WS_LB = WS_MOD + (size_t)DEPTH * 9 * 6144 * 4;
constexpr size_t WS_MT = WS_LB + (size_t)DEPTH * 512 * 4;
constexpr size_t WS_DEN = WS_MT + (size_t)2 * MTOT * 4 * 4;
constexpr size_t WS_BAR = WS_DEN + (size_t)2 * MTOT * 4 * 4;
constexpr size_t WS_HALO = WS_BAR + 8192;
constexpr size_t WS_OI = WS_HALO + (size_t)272 * 2 * 2048 * 2;
constexpr size_t WS_QB = WS_OI + (size_t)MTOT * 512 * 2;
constexpr size_t WS_DEC = WS_QB + (size_t)MTOT * 512 * 2;
constexpr size_t WS_END = WS_DEC + (size_t)8 * 4 * 68 * 2 * 128 * 4;
constexpr int LDS_BYTES = 147456;

#ifndef DBG_SKIP_P3
#define DBG_SKIP_P3 0
#endif
#ifndef DBG_SKIP_P4
#define DBG_SKIP_P4 0
#endif
#ifndef DBG_NO_M
#define DBG_NO_M 0
#endif
#ifndef DBG_NO_H
#define DBG_NO_H 0
#endif
#ifndef DBG_NO_A
#define DBG_NO_A 0
#endif
#ifndef P2_WGM
#define P2_WGM 4
#endif
struct Params { const float* in[17]; float* out; u8* ws; };

typedef __bf16 bf16x2_t __attribute__((ext_vector_type(2)));
typedef float f32x2_t __attribute__((ext_vector_type(2)));
DI unsigned cvt_pk_bf16(float lo, float hi) { f32x2_t v = {lo, hi}; bf16x2_t b = __builtin_convertvector(v, bf16x2_t); return __builtin_bit_cast(unsigned, b); }
DI float bf_lo(unsigned u) { return __uint_as_float(u << 16); }
DI float bf_hi(unsigned u) { return __uint_as_float(u & 0xffff0000u); }
DI float rcpf_(float x) { return __builtin_amdgcn_rcpf(x); }
DI float sigmoidf_(float x) { return rcpf_(1.0f + __expf(-x)); }
DI float siluf_(float x) { return x * rcpf_(1.0f + __expf(-x)); }
DI float logsigf_(float x) { return fminf(x, 0.f) - __logf(1.0f + __expf(-fabsf(x))); }
DI void unpack8(const u32x4 r, float (&x)[8]) {
    x[0] = bf_lo(r.x); x[1] = bf_hi(r.x); x[2] = bf_lo(r.y); x[3] = bf_hi(r.y); x[4] = bf_lo(r.z); x[5] = bf_hi(r.z); x[6] = bf_lo(r.w); x[7] = bf_hi(r.w);
}
DI unsigned half_sel(unsigned u, int hi) { return hi ? (u >> 16) : (u & 0xffffu); }

template <int NT, int KS>
DI void mma_rows(const LAS u8* A, int lda, int m0, const LAS u8* Bm, int ldb, int n0, f32x4 (&acc)[NT], int fr, int fq) {
    const LAS u8* ap = A + (m0 + fr) * lda + fq * 16;
    const LAS u8* bp = Bm + (n0 + fr) * ldb + fq * 16;
#pragma unroll
    for (int ks = 0; ks < KS; ++ks) {
        const bf16x8 a = *(const LAS bf16x8*)(ap + ks * 64);
#pragma unroll
        for (int nt = 0; nt < NT; ++nt) {
            const bf16x8 b = *(const LAS bf16x8*)(bp + nt * 16 * ldb + ks * 64);
            acc[nt] = __builtin_amdgcn_mfma_f32_16x16x32_bf16(b, a, acc[nt], 0, 0, 0);
        }
    }
}

typedef short s16x4 __attribute__((ext_vector_type(4)));
DI bf16x8 ldfrag_tr(const LAS u8* T, int ld, int k0, int c0, int lane) {
    const int g = lane >> 4, q = (lane >> 2) & 3, p = lane & 3;
    const LAS u8* a = T + (k0 + 8 * g + q) * ld + (c0 + 4 * p) * 2;
    const s16x4 lo = __builtin_amdgcn_ds_read_tr16_b64_v4i16((LAS s16x4*)a);
    const s16x4 hi = __builtin_amdgcn_ds_read_tr16_b64_v4i16((LAS s16x4*)(a + 4 * ld));
    return __builtin_shufflevector(lo, hi, 0, 1, 2, 3, 4, 5, 6, 7);
}
template <int NT, int KS, bool TA, bool TB>
DI void mma_gen(const LAS u8* A, int lda, int m0, const LAS u8* Bm, int ldb, int n0, f32x4 (&acc)[NT], int lane) {
    const int fr = lane & 15, fq = lane >> 4;
#pragma unroll
    for (int ks = 0; ks < KS; ++ks) {
        bf16x8 a;
        if (TA) a = ldfrag_tr(A, lda, ks * 32, m0, lane); else a = *(const LAS bf16x8*)(A + (m0 + fr) * lda + fq * 16 + ks * 64);
#pragma unroll
        for (int nt = 0; nt < NT; ++nt) {
            bf16x8 b;
            if (TB) b = ldfrag_tr(Bm, ldb, ks * 32, n0 + nt * 16, lane); else b = *(const LAS bf16x8*)(Bm + (n0 + nt * 16 + fr) * ldb + fq * 16 + ks * 64);
            acc[nt] = __builtin_amdgcn_mfma_f32_16x16x32_bf16(b, a, acc[nt], 0, 0, 0);
        }
    }
}

template <int MT, int NT, int KS, bool TA, bool TB>
DI void mma_tile(const LAS u8* A, int lda, int m0, const LAS u8* Bm, int ldb, int n0, f32x4 (&acc)[MT][NT], int lane) {
    const int fr = lane & 15, fq = lane >> 4;
#pragma unroll 1
    for (int ks = 0; ks < KS; ++ks) {
        bf16x8 a[MT], b[NT];
#pragma unroll
        for (int mt = 0; mt < MT; ++mt) { if (TA) a[mt] = ldfrag_tr(A, lda, ks * 32, m0 + mt * 16, lane); else a[mt] = *(const LAS bf16x8*)(A + (m0 + mt * 16 + fr) * lda + fq * 16 + ks * 64); }
#pragma unroll
        for (int nt = 0; nt < NT; ++nt) { if (TB) b[nt] = ldfrag_tr(Bm, ldb, ks * 32, n0 + nt * 16, lane); else b[nt] = *(const LAS bf16x8*)(Bm + (n0 + nt * 16 + fr) * ldb + fq * 16 + ks * 64); }
#pragma unroll
        for (int mt = 0; mt < MT; ++mt)
#pragma unroll
            for (int nt = 0; nt < NT; ++nt) acc[mt][nt] = __builtin_amdgcn_mfma_f32_16x16x32_bf16(b[nt], a[mt], acc[mt][nt], 0, 0, 0);
    }
}

namespace pg8 {
constexpr int BM = 256, BK = 64, HALF = 128, HTB = HALF * BK * 2, STAGE_BYTES = 8 * HTB, NXCD = 8, WGM = 8;
DI int lds_byte(int r, int c) { const int st = (r >> 4) * 2 + (c >> 5), rr = r & 15, cc = c & 31, ob = rr * 64 + cc * 2; return st * 1024 + (ob ^ (((ob >> 9) & 1) << 5)); }
DI void stage_rc(int b, int& R, int& C) { const int st = b / 1024, sb = b % 1024, swz = sb ^ (((sb >> 9) & 1) << 5); R = (st >> 1) * 16 + swz / 64; C = (st & 1) * 32 + (swz % 64) / 2; }
DI int perm32(int rho) { const int n = rho >> 4, i = rho & 15; return 8 * (i >> 2) + 4 * n + (i & 3); }
struct Unit { int pm, pn; };
struct Gemm { const bf16_t* A; const bf16_t* Bt; int M, N, K; };
struct StaticOrder {
    int nM, nN, nwg, G, c, wgm;
    DI void init(int M, int N, int G_, int c_, int wgm_ = WGM) { nM = M / BM; nN = N / BM; nwg = nM * nN; G = G_; c = c_; wgm = wgm_; }
    DI bool next(int i, Unit& u) const {
        const long L = (long)i * G + c; if (L >= nwg) return false;
        int wgid = (int)L; { const int q = nwg / NXCD, r = nwg % NXCD, xcd = wgid % NXCD, off = wgid / NXCD; wgid = (xcd < r ? xcd * (q + 1) : r * (q + 1) + (xcd - r) * q) + off; }
        const int nig = wgm * nN, gid = wgid / nig, fm = gid * wgm, gsz = (nM - fm) < wgm ? (nM - fm) : wgm;
        u.pm = fm + ((wgid % nig) % gsz); u.pn = (wgid % nig) / gsz; return true;
    }
};

template <class Epi>
DI void gemm_phase(LAS u8* lds, const Gemm g, const StaticOrder& S, const Epi& E, const int tid) {
    const int wid = __builtin_amdgcn_readfirstlane(tid >> 6), lane = tid & 63, wr = wid >> 2, wc = wid & 3, fr = lane & 15, fq = lane >> 4;
    const int K = g.K, nt = K / BK;
    unsigned voffA[2], voffB[2];
#pragma unroll
    for (int i = 0; i < 2; ++i) { int R, C; stage_rc(tid * 16 + i * 8192, R, C); const int Rb = Epi::PERM ? ((R & ~31) + perm32(R & 31)) : R;
        voffA[i] = (unsigned)(R * K + C) * 2u; voffB[i] = (unsigned)(Rb * K + C) * 2u; }
    const size_t kstep = (size_t)(BK * 2);
    const size_t hstep = (size_t)HALF * K * 2;
    const size_t tstep = 2 * hstep;
    const unsigned ldsw = (unsigned)wid * 1024u;
    const int aoff = lds_byte(wr * 64 + fr, fq * 8), boff = lds_byte(wc * 32 + fr, fq * 8);
#define PG8_SA(b, h) (((b) * 2 + (h)) * HTB)
#define PG8_SB(b, h) ((4 + (b) * 2 + (h)) * HTB)
#define PG8_STAGE(bufoff, gbase, voff) do { _Pragma("unroll") for (int _i = 0; _i < 2; ++_i) \
        __builtin_amdgcn_global_load_lds((const unsigned*)((const char*)(gbase) + (voff)[_i]), (LAS unsigned*)(lds + (bufoff) + ldsw + _i * 8192), 16, 0, 0); } while (0)
#define PG8_LDA(dst, b, h) do { _Pragma("unroll") for (int m = 0; m < 4; ++m) _Pragma("unroll") for (int k = 0; k < 2; ++k) dst[m][k] = *(const LAS bf16x8*)(lds + PG8_SA(b, h) + aoff + m * 2048 + k * 1024); } while (0)
#define PG8_LDB(dst, b, h) do { _Pragma("unroll") for (int n = 0; n < 2; ++n) _Pragma("unroll") for (int k = 0; k < 2; ++k) dst[n][k] = *(const LAS bf16x8*)(lds + PG8_SB(b, h) + boff + n * 2048 + k * 1024); } while (0)
#define PG8_MMA(ai, bj, At, Bt) do { __builtin_amdgcn_s_setprio(1); _Pragma("unroll") for (int m = 0; m < 4; ++m) _Pragma("unroll") for (int n = 0; n < 2; ++n) _Pragma("unroll") for (int k = 0; k < 2; ++k) \
        acc[ai][bj][m][n] = __builtin_amdgcn_mfma_f32_16x16x32_bf16(Bt[n][k], At[m][k], acc[ai][bj][m][n], 0, 0, 0); __builtin_amdgcn_s_setprio(0); } while (0)
#define PG8_WAIT_V(n) asm volatile("s_waitcnt vmcnt(" #n ")" ::: "memory")
#define PG8_WAIT_L(n) asm volatile("s_waitcnt lgkmcnt(" #n ")" ::: "memory")
#define PG8_BAR __builtin_amdgcn_s_barrier()
#define PG8_SCHED __builtin_amdgcn_sched_barrier(0)
    Unit cur, nxt; int ui = 0;
    if (!S.next(0, cur)) return;
    f32x4 acc[2][2][4][2];
#pragma unroll
    for (int a = 0; a < 2; ++a)
#pragma unroll
        for (int b = 0; b < 2; ++b)
#pragma unroll
            for (int m = 0; m < 4; ++m)
#pragma unroll
                for (int n = 0; n < 2; ++n) acc[a][b][m][n] = (f32x4){0.f, 0.f, 0.f, 0.f};
    bf16x8 At[4][2], B0[2][2], B1[2][2];
    const char* cA = (const char*)g.A + (size_t)cur.pm * tstep; const char* cB = (const char*)g.Bt + (size_t)cur.pn * tstep;
    PG8_STAGE(PG8_SB(0, 0), cB, voffB); PG8_STAGE(PG8_SA(0, 0), cA, voffA); PG8_STAGE(PG8_SB(0, 1), cB + hstep, voffB); PG8_STAGE(PG8_SA(0, 1), cA + hstep, voffA);
    if (wr == 1) PG8_BAR;
    PG8_WAIT_V(4); PG8_BAR;
    PG8_STAGE(PG8_SB(1, 0), cB + kstep, voffB); PG8_STAGE(PG8_SA(1, 0), cA + kstep, voffA); PG8_STAGE(PG8_SB(1, 1), cB + hstep + kstep, voffB);
    PG8_WAIT_V(6); PG8_BAR;
    for (;;) {
        const bool has_next = S.next(ui + 1, nxt);
        const char* nA = has_next ? (const char*)g.A + (size_t)nxt.pm * tstep : cA; const char* nB = has_next ? (const char*)g.Bt + (size_t)nxt.pn * tstep : cB;
        for (int t = 0; t < nt; t += 2) {
            const bool last = (t == nt - 2);
            const char* a1 = cA + (size_t)(t + 1) * kstep;
            const char* a2 = last ? nA : cA + (size_t)(t + 2) * kstep; const char* b2 = last ? nB : cB + (size_t)(t + 2) * kstep;
            const char* a3 = a2 + kstep; const char* b3 = b2 + kstep;
            PG8_LDB(B0, 0, 0); PG8_SCHED; PG8_LDA(At, 0, 0); PG8_STAGE(PG8_SA(1, 1), a1 + hstep, voffA);
            PG8_WAIT_L(8); PG8_BAR; PG8_WAIT_L(0); PG8_MMA(0, 0, At, B0); PG8_BAR; PG8_SCHED;
            PG8_LDB(B1, 0, 1); PG8_STAGE(PG8_SB(0, 0), b2, voffB);
            PG8_BAR; PG8_WAIT_L(0); PG8_MMA(0, 1, At, B1); PG8_BAR;
            PG8_LDA(At, 0, 1); PG8_STAGE(PG8_SA(0, 0), a2, voffA);
            PG8_BAR; PG8_WAIT_L(0); PG8_MMA(1, 0, At, B0); PG8_BAR; PG8_SCHED;
            PG8_STAGE(PG8_SB(0, 1), b2 + hstep, voffB);
            PG8_WAIT_V(6); PG8_BAR; PG8_MMA(1, 1, At, B1); PG8_BAR;
            PG8_LDB(B0, 1, 0); PG8_SCHED; PG8_LDA(At, 1, 0); PG8_STAGE(PG8_SA(0, 1), a2 + hstep, voffA);
            PG8_WAIT_L(8); PG8_BAR; PG8_WAIT_L(0); PG8_MMA(0, 0, At, B0); PG8_BAR; PG8_SCHED;
            PG8_LDB(B1, 1, 1); PG8_STAGE(PG8_SB(1, 0), b3, voffB);
            PG8_BAR; PG8_WAIT_L(0); PG8_MMA(0, 1, At, B1); PG8_BAR;
            PG8_LDA(At, 1, 1); PG8_STAGE(PG8_SA(1, 0), a3, voffA);
            PG8_BAR; PG8_WAIT_L(0); PG8_MMA(1, 0, At, B0); PG8_BAR; PG8_SCHED;
            PG8_STAGE(PG8_SB(1, 1), b3 + hstep, voffB);
            PG8_WAIT_V(6); PG8_BAR; PG8_MMA(1, 1, At, B1); PG8_BAR;
        }
        E(acc, cur, wr, wc, fr, fq);
        if (!has_next) break;
#pragma unroll
        for (int a = 0; a < 2; ++a)
#pragma unroll
            for (int b = 0; b < 2; ++b)
#pragma unroll
                for (int m = 0; m < 4; ++m)
#pragma unroll
                    for (int n = 0; n < 2; ++n) acc[a][b][m][n] = (f32x4){0.f, 0.f, 0.f, 0.f};
        cur = nxt; cA = nA; cB = nB; ++ui;
    }
    PG8_WAIT_V(0);
    if (wr == 0) PG8_BAR;
    PG8_BAR;
#undef PG8_SA
#undef PG8_SB
#undef PG8_STAGE
#undef PG8_LDA
#undef PG8_LDB
#undef PG8_MMA
#undef PG8_WAIT_V
#undef PG8_WAIT_L
#undef PG8_BAR
#undef PG8_SCHED
}

struct EpiP {
    static constexpr bool PERM = true;
    bf16_t* Pb; float* gates; const float* bias; bf16_t* halo;
    DI void operator()(const f32x4 (&acc)[2][2][4][2], const Unit& u, int wr, int wc, int fr, int fq) const {
        const int row0 = u.pm * BM + wr * 64 + fr;
        if (u.pn < 36) {
            const int col0 = u.pn * BM + wc * 32 + 8 * fq;
            f32x4 bv[2][2];
#pragma unroll
            for (int bj = 0; bj < 2; ++bj) { const int c = col0 + bj * HALF; const int oc = c < 6656 ? c : c + 16;
                bv[bj][0] = *(const f32x4*)(bias + oc); bv[bj][1] = *(const f32x4*)(bias + oc + 4); }
#pragma unroll
            for (int ai = 0; ai < 2; ++ai)
#pragma unroll
                for (int m = 0; m < 4; ++m) { bf16_t* rowp = Pb + (size_t)(row0 + ai * HALF + m * 16) * PW + col0;
#pragma unroll
                    for (int bj = 0; bj < 2; ++bj) { const f32x4 v0 = acc[ai][bj][m][0] + bv[bj][0], v1 = acc[ai][bj][m][1] + bv[bj][1];
                        u32x4 w; w.x = cvt_pk_bf16(v0[0], v0[1]); w.y = cvt_pk_bf16(v0[2], v0[3]); w.z = cvt_pk_bf16(v1[0], v1[1]); w.w = cvt_pk_bf16(v1[2], v1[3]);
                        *(u32x4*)(rowp + bj * HALF) = w;
                        if (u.pn >= 6 && u.pn < 14) {
                            const int rr = wr * 64 + m * 16 + fr;
                            if (rr == 0 || rr == 127) *(u32x4*)(halo + ((size_t)((row0 + ai * HALF + m * 16) >> 7) * 2 + (rr ? 1 : 0)) * 2048 + (col0 - 1536) + bj * HALF) = w; } } }
        } else if (wc == 0 && fq < 2) {
            const f32x4 b0 = *(const f32x4*)(bias + 6656 + 8 * fq), b1 = *(const f32x4*)(bias + 6656 + 8 * fq + 4);
#pragma unroll
            for (int ai = 0; ai < 2; ++ai)
#pragma unroll
                for (int m = 0; m < 4; ++m) { float* gp = gates + (size_t)(row0 + ai * HALF + m * 16) * 16 + 8 * fq;
                    *(f32x4*)(gp) = acc[ai][0][m][0] + b0; *(f32x4*)(gp + 4) = acc[ai][0][m][1] + b1; }
        }
    }
};
struct EpiH {
    static constexpr bool PERM = true;
    const float* x_in; bf16_t* hb; bf16_t* hb_last; const float* hc_in; float* hc_out; const float* mod; int first, lastl;
    DI void operator()(const f32x4 (&acc)[2][2][4][2], const Unit& u, int wr, int wc, int fr, int fq) const {
        const int row0 = u.pm * BM + wr * 64 + fr, col0 = u.pn * BM + wc * 32 + 8 * fq;
        const bool lat = (u.pm * BM) < MLAT;
        const int b = lat ? ((u.pm * BM) >> 12) : 8;
        const float* gg = mod + b * 6144 + 4096 + col0;
        f32x4 gv[2][2];
#pragma unroll
        for (int bj = 0; bj < 2; ++bj)
#pragma unroll
            for (int n = 0; n < 2; ++n) gv[bj][n] = *(const f32x4*)(gg + bj * HALF + n * 4);
        if (lat && !first) {
#pragma unroll
            for (int ai = 0; ai < 2; ++ai) {
                u32x4 hv[4][2];
#pragma unroll
                for (int m = 0; m < 4; ++m) { const bf16_t* src = hb + (size_t)(row0 + ai * HALF + m * 16) * DM + col0;
#pragma unroll
                    for (int bj = 0; bj < 2; ++bj) hv[m][bj] = *(const u32x4*)(src + bj * HALF); }
#pragma unroll
                for (int m = 0; m < 4; ++m) { const size_t off = (size_t)(row0 + ai * HALF + m * 16) * DM + col0;
#pragma unroll
                    for (int bj = 0; bj < 2; ++bj) { float h8[8]; unpack8(hv[m][bj], h8);
                        const f32x4 o0 = (f32x4){h8[0], h8[1], h8[2], h8[3]} + gv[bj][0] * acc[ai][bj][m][0], o1 = (f32x4){h8[4], h8[5], h8[6], h8[7]} + gv[bj][1] * acc[ai][bj][m][1];
                        u32x4 w; w.x = cvt_pk_bf16(o0[0], o0[1]); w.y = cvt_pk_bf16(o0[2], o0[3]); w.z = cvt_pk_bf16(o1[0], o1[1]); w.w = cvt_pk_bf16(o1[2], o1[3]);
                        *(u32x4*)((lastl ? hb_last : hb) + off + bj * HALF) = w; } }
            }
        } else {
#pragma unroll
            for (int ai = 0; ai < 2; ++ai)
#pragma unroll
                for (int m = 0; m < 4; m += 2) {
                    f32x4 hv[2][2][2];
#pragma unroll
                    for (int m2 = 0; m2 < 2; ++m2) { const int row = row0 + ai * HALF + (m + m2) * 16;
                        const float* src = (lat ? x_in + (size_t)row * DM : hc_in + (size_t)(row - MLAT) * DM) + col0;
#pragma unroll
                        for (int bj = 0; bj < 2; ++bj)
#pragma unroll
                            for (int n = 0; n < 2; ++n) hv[m2][bj][n] = *(const f32x4*)(src + bj * HALF + n * 4); }
#pragma unroll
                    for (int m2 = 0; m2 < 2; ++m2) { const int row = row0 + ai * HALF + (m + m2) * 16;
#pragma unroll
                        for (int bj = 0; bj < 2; ++bj) { const f32x4 o0 = hv[m2][bj][0] + gv[bj][0] * acc[ai][bj][m + m2][0], o1 = hv[m2][bj][1] + gv[bj][1] * acc[ai][bj][m + m2][1];
                            if (!lat) { float* dst = hc_out + (size_t)(row - MLAT) * DM + col0 + bj * HALF; *(f32x4*)(dst) = o0; *(f32x4*)(dst + 4) = o1; }
                            else { u32x4 w; w.x = cvt_pk_bf16(o0[0], o0[1]); w.y = cvt_pk_bf16(o0[2], o0[3]); w.z = cvt_pk_bf16(o1[0], o1[1]); w.w = cvt_pk_bf16(o1[2], o1[3]); *(u32x4*)((lastl ? hb_last : hb) + (size_t)row * DM + col0 + bj * HALF) = w; } } }
                }
        }
    }
};
}

DI void phase0(const Params& P, LAS u8* lds, int tid) {
    LAS float* s = (LAS float*)lds;
    LAS float* red = (LAS float*)(lds + 73728);
    const float* c = P.in[1]; const float* cctx = P.in[3]; const float* w_ada = P.in[4]; const float* b_ada = P.in[5];
    float* mod = (float*)(P.ws + WS_MOD);
    for (int i = tid; i < 9 * 2048; i += 512) { const float v = i < 8 * 2048 ? c[i] : cctx[i - 8 * 2048]; s[i] = siluf_(v); }
    if (blockIdx.x == 0) {
        const float* lg = P.in[13]; float* lb = (float*)(P.ws + WS_LB);
        const float a0 = lg[tid], a1 = lg[512 + tid], a2 = lg[1024 + tid], a3 = lg[1536 + tid];
        const float mx = fmaxf(fmaxf(a0, a1), fmaxf(a2, a3));
        const float e0 = expf(a0 - mx), e1 = expf(a1 - mx), e2 = expf(a2 - mx), e3 = expf(a3 - mx);
        const float inv = 1.0f / (e0 + e1 + e2 + e3);
        const float p0 = e0 * inv, p1 = e1 * inv, p2 = e2 * inv, p3 = e3 * inv;
        lb[tid] = p0 - p0; lb[512 + tid] = (p0 + p1) - p0; lb[1024 + tid] = (p0 + p1 + p2) - p0; lb[1536 + tid] = (p0 + p1 + p2 + p3) - p0;
    }
    __syncthreads();
    const int w = tid >> 6, lane = tid & 63, cgp = lane & 15, kq = lane >> 4;
    for (int task = blockIdx.x; task < 384; task += gridDim.x) {
        const int l = task / 96, cb = task % 96;
        const float* W = w_ada + (size_t)l * 2048 * 6144 + cb * 64 + cgp * 4;
        f32x4 acc[9];
#pragma unroll
        for (int b = 0; b < 9; ++b) acc[b] = (f32x4){0.f, 0.f, 0.f, 0.f};
#pragma unroll 4
        for (int kk = 0; kk < 64; ++kk) {
            const int k = w * 256 + kk * 4 + kq;
            const f32x4 wv = __builtin_nontemporal_load((const f32x4*)(W + (size_t)k * 6144));
#pragma unroll
            for (int b = 0; b < 9; ++b) acc[b] += s[b * 2048 + k] * wv;
        }
#pragma unroll
        for (int b = 0; b < 9; ++b)
#pragma unroll
            for (int j = 0; j < 4; ++j) { float v = acc[b][j]; v += __shfl_xor(v, 16); v += __shfl_xor(v, 32); if (kq == 0) red[(w * 9 + b) * 64 + cgp * 4 + j] = v; }
        __syncthreads();
        for (int i = tid; i < 576; i += 512) { const int b = i >> 6, cc = i & 63; float v = b_ada[l * 6144 + cb * 64 + cc];
#pragma unroll
            for (int ww = 0; ww < 8; ++ww) v += red[(ww * 9 + b) * 64 + cc];
            mod[(size_t)(l * 9 + b) * 6144 + cb * 64 + cc] = v; }
        __syncthreads();
    }
}

DI void conv_tile256(const float* src, int ld, int nvalid, bf16_t* dst, LAS float* tile, int tid) {
    f32x4 v[8];
#pragma unroll
    for (int it = 0; it < 8; ++it) { const int idx = it * 512 + tid, k = idx >> 6, n = (idx & 63) * 4;
        v[it] = (f32x4){0.f, 0.f, 0.f, 0.f};
        if (n < nvalid) v[it] = __builtin_nontemporal_load((const f32x4*)(src + (size_t)k * ld + n)); }
#pragma unroll
    for (int it = 0; it < 8; ++it) { const int idx = it * 512 + tid, k = idx >> 6, n = (idx & 63) * 4;
        tile[k * 257 + n + 0] = v[it][0]; tile[k * 257 + n + 1] = v[it][1]; tile[k * 257 + n + 2] = v[it][2]; tile[k * 257 + n + 3] = v[it][3]; }
    __syncthreads();
    const int kg = tid & 7;
#pragma unroll
    for (int p = 0; p < 4; ++p) { const int nr = p * 64 + (tid >> 3);
        float x[8];
#pragma unroll
        for (int j = 0; j < 8; ++j) x[j] = tile[(kg * 8 + j) * 257 + nr];
        u32x4 w; w.x = cvt_pk_bf16(x[0], x[1]); w.y = cvt_pk_bf16(x[2], x[3]); w.z = cvt_pk_bf16(x[4], x[5]); w.w = cvt_pk_bf16(x[6], x[7]);
        *(u32x4*)(dst + (size_t)nr * DM + kg * 8) = w; }
    __syncthreads();
}

DI void phase1(const Params& P, int l, LAS u8* lds, int tid) {
    const float* hl = P.in[0]; const bf16_t* hb = (const bf16_t*)P.out; const float* hc = l == 0 ? P.in[2] : (const float*)(P.ws + WS_HCTX);
    const float* mod = (const float*)(P.ws + WS_MOD) + (size_t)l * 9 * 6144;
    const float* ng = P.in[6] + l * DM;
    bf16_t* N = (bf16_t*)(P.ws + WS_N);
    const int w = tid >> 6, lane = tid & 63;
    for (int grp = blockIdx.x; grp < MTOT / 32; grp += gridDim.x) {
        const int r0 = grp * 32 + w * 4;
        const int b = r0 < MLAT ? (r0 >> 12) : 8;
        const float* mb = mod + b * 6144;
        f32x4 gm[8], sh[8];
#pragma unroll
        for (int i = 0; i < 8; ++i) { const int c = (i * 64 + lane) * 4;
            const f32x4 g4 = *(const f32x4*)(ng + c), sc = *(const f32x4*)(mb + 2048 + c);
            gm[i] = g4 * (1.0f + sc); sh[i] = *(const f32x4*)(mb + c); }
#pragma unroll 1
        for (int r = 0; r < 4; ++r) { const int row = r0 + r;
            f32x4 x[8]; float ss = 0.f;
            if (row < MLAT && l > 0) {
                const bf16_t* srcb = hb + (size_t)row * DM;
#pragma unroll
                for (int i = 0; i < 8; ++i) { const u32x2 r2 = __builtin_nontemporal_load((const u32x2*)(srcb + (i * 64 + lane) * 4)); x[i] = (f32x4){bf_lo(r2.x), bf_hi(r2.x), bf_lo(r2.y), bf_hi(r2.y)}; }
            } else {
                const float* src = row < MLAT ? hl + (size_t)row * DM : hc + (size_t)(row - MLAT) * DM;
#pragma unroll
                for (int i = 0; i < 8; ++i) x[i] = __builtin_nontemporal_load((const f32x4*)(src + (i * 64 + lane) * 4));
            }
#pragma unroll
            for (int i = 0; i < 8; ++i) ss += x[i][0] * x[i][0] + x[i][1] * x[i][1] + x[i][2] * x[i][2] + x[i][3] * x[i][3];
#pragma unroll
            for (int o = 32; o >= 1; o >>= 1) ss += __shfl_xor(ss, o);
            const float rstd = rsqrtf(ss * (1.0f / DM) + EPS);
            bf16_t* dst = N + (size_t)row * DM;
#pragma unroll
            for (int i = 0; i < 8; ++i) { const f32x4 y = x[i] * rstd * gm[i] + sh[i];
                u32x2 pk; pk.x = cvt_pk_bf16(y[0], y[1]); pk.y = cvt_pk_bf16(y[2], y[3]);
                *(u32x2*)(dst + (i * 64 + lane) * 4) = pk; } }
    }
    LAS float* tile = (LAS float*)lds;
    const float* win = P.in[7] + (size_t)l * DM * DIN; const float* wout = P.in[15] + (size_t)l * DM * DM;
    bf16_t* WinT = (bf16_t*)(P.ws + WS_WIN); bf16_t* WoutT = (bf16_t*)(P.ws + WS_WOUT);
    constexpr int NT_IN = (NGEMM / 256) * 32, NT_OUT = 8 * 32;
    for (int t = blockIdx.x; t < NT_IN + NT_OUT; t += gridDim.x) {
        if (t < NT_IN) { const int nt = t >> 5, kt = t & 31; const int np = nt * 256;
            int nsrc, nvalid;
            if (np < 6656) { nsrc = np; nvalid = 256; } else if (np < 9216) { nsrc = np + 16; nvalid = 256; } else { nsrc = 6656; nvalid = 16; }
            conv_tile256(win + (size_t)(kt * 64) * DIN + nsrc, DIN, nvalid, WinT + (size_t)np * DM + kt * 64, tile, tid);
        } else { const int tt = t - NT_IN; const int nt = tt >> 5, kt = tt & 31;
            conv_tile256(wout + (size_t)(kt * 64) * DM + nt * 256, DM, 256, WoutT + (size_t)(nt * 256) * DM + kt * 64, tile, tid); }
    }
}

DI void task_chunkmlp(const Params& P, int l, int cidx, int g, LAS u8* lds, int tid) {
    LAS u8* wsA = lds; LAS u8* vnT = lds + 34816;
    const bf16_t* Pb = (const bf16_t*)(P.ws + WS_P); bf16_t* mix = (bf16_t*)(P.ws + WS_N);
    const int w = tid >> 6, lane = tid & 63, fr = lane & 15, fq = lane >> 4;
    const int R0 = cidx * 128;
    const float* Ws = P.in[9] + (size_t)(l * 4 + g) * 16384;
#pragma unroll
    for (int i = 0; i < 8; ++i) { const int idx = i * 512 + tid, t = idx >> 5, s4 = (idx & 31) * 4;
        const f32x4 v = *(const f32x4*)(Ws + t * 128 + s4);
        u32x2 pk; pk.x = cvt_pk_bf16(v[0], v[1]); pk.y = cvt_pk_bf16(v[2], v[3]);
        *(LAS u32x2*)(wsA + t * 272 + s4 * 2) = pk; }
    {
        const int s = tid >> 2, qd = tid & 3;
        const bf16_t* vp = Pb + (size_t)(R0 + s) * PW + PC_AV + g * 128 + qd * 32;
        float x[32];
#pragma unroll
        for (int i = 0; i < 4; ++i) { const u32x4 r = *(const u32x4*)(vp + i * 8); float t8[8]; unpack8(r, t8);
#pragma unroll
            for (int j = 0; j < 8; ++j) x[i * 8 + j] = t8[j]; }
        float sm = 0.f;
#pragma unroll
        for (int i = 0; i < 32; ++i) sm += x[i];
        sm += __shfl_xor(sm, 1); sm += __shfl_xor(sm, 2);
        const float mu = sm * (1.0f / 128.0f);
        float vq = 0.f;
#pragma unroll
        for (int i = 0; i < 32; ++i) { x[i] -= mu; vq += x[i] * x[i]; }
        vq += __shfl_xor(vq, 1); vq += __shfl_xor(vq, 2);
        const float rs = rsqrtf(vq * (1.0f / 128.0f) + EPS);
#pragma unroll
        for (int i = 0; i < 32; i += 2) { const unsigned pk = cvt_pk_bf16(x[i] * rs, x[i + 1] * rs);
            *(LAS bf16_t*)(vnT + (qd * 32 + 16 * ((i >> 2) & 1) + 4 * (i >> 3) + (i & 3)) * 272 + s * 2) = (bf16_t)(pk & 0xffffu);
            *(LAS bf16_t*)(vnT + (qd * 32 + 16 * (((i + 1) >> 2) & 1) + 4 * ((i + 1) >> 3) + ((i + 1) & 3)) * 272 + s * 2) = (bf16_t)(pk >> 16); }
    }
    __syncthreads();
    f32x4 acc[8];
#pragma unroll
    for (int i = 0; i < 8; ++i) acc[i] = (f32x4){0.f, 0.f, 0.f, 0.f};
    mma_rows<8, 4>(wsA, 272, 16 * w, vnT, 272, 0, acc, fr, fq);
    const int t = 16 * w + fr; const size_t R = (size_t)(R0 + t);
    const float bs = P.in[10][(l * 4 + g) * 128 + t];
#pragma unroll
    for (int gp = 0; gp < 4; ++gp) { const int c = g * 128 + gp * 32 + 8 * fq;
        const u32x4 ur = *(const u32x4*)(Pb + R * PW + PC_AU + c), zr = *(const u32x4*)(Pb + R * PW + PC_AZ + c);
        float uf[8], zf[8]; unpack8(ur, uf); unpack8(zr, zf);
        float y[8];
#pragma unroll
        for (int j = 0; j < 4; ++j) { y[j] = uf[j] * (acc[2 * gp][j] + bs) * siluf_(zf[j]); y[4 + j] = uf[4 + j] * (acc[2 * gp + 1][j] + bs) * siluf_(zf[4 + j]); }
        u32x4 pk; pk.x = cvt_pk_bf16(y[0], y[1]); pk.y = cvt_pk_bf16(y[2], y[3]); pk.z = cvt_pk_bf16(y[4], y[5]); pk.w = cvt_pk_bf16(y[6], y[7]);
        *(u32x4*)(mix + R * DM + c) = pk; }
    __syncthreads();
}

DI void task_conv(const Params& P, int l, int chunk, int isk, int h, int tid) {
    bf16_t* Pb = (bf16_t*)(P.ws + WS_P); const bf16_t* halo = (const bf16_t*)(P.ws + WS_HALO);
    const int cg = tid & 31, rg = tid >> 5; const int d0 = cg * 8, t0 = rg * 8;
    const int R0 = chunk * 128;
    const bool has_prev = (chunk < 256) ? ((chunk & 31) != 0) : ((chunk & 1) != 0);
    const bool has_next = (chunk < 256) ? ((chunk & 31) != 31) : ((chunk & 1) != 1);
    const float* cw = P.in[11] + (size_t)l * 3 * 2048 + isk * 1024 + h * 256;
    const float scale = isk ? 0.0625f : 1.0f;
    const int hc = isk * 1024 + h * 256 + d0;
    bf16_t* base = Pb + (size_t)(R0 + t0) * PW + PC_BQ + hc;
    u32x4 raw[10];
#pragma unroll
    for (int r = 1; r < 9; ++r) raw[r] = *(const u32x4*)(base + (ptrdiff_t)(r - 1) * PW);
    raw[0] = (u32x4){0u, 0u, 0u, 0u}; raw[9] = raw[0];
    if (t0 > 0) raw[0] = *(const u32x4*)(base - (ptrdiff_t)PW);
    else if (has_prev) raw[0] = *(const u32x4*)(halo + ((size_t)(chunk - 1) * 2 + 1) * 2048 + hc);
    if (t0 < 120) raw[9] = *(const u32x4*)(base + (ptrdiff_t)8 * PW);
    else if (has_next) raw[9] = *(const u32x4*)(halo + ((size_t)(chunk + 1) * 2 + 0) * 2048 + hc);
    float w0[8], w1[8], w2[8];
#pragma unroll
    for (int hh = 0; hh < 2; ++hh) { const f32x4 a = *(const f32x4*)(cw + d0 + 4 * hh), b = *(const f32x4*)(cw + 2048 + d0 + 4 * hh), c = *(const f32x4*)(cw + 4096 + d0 + 4 * hh);
#pragma unroll
        for (int j = 0; j < 4; ++j) { w0[4 * hh + j] = a[j]; w1[4 * hh + j] = b[j]; w2[4 * hh + j] = c[j]; } }
    asm volatile("s_waitcnt vmcnt(0)" ::: "memory");
    __syncthreads();
    float xp[8], xc[8], xn[8];
    unpack8(raw[0], xp); unpack8(raw[1], xc);
#pragma unroll
    for (int r = 0; r < 8; ++r) {
        unpack8(raw[r + 2], xn);
        float y[8];
#pragma unroll
        for (int c = 0; c < 8; ++c) { const float v = w0[c] * xp[c] + w1[c] * xc[c] + w2[c] * xn[c]; y[c] = siluf_(v) * scale; }
        u32x4 o; o.x = cvt_pk_bf16(y[0], y[1]); o.y = cvt_pk_bf16(y[2], y[3]); o.z = cvt_pk_bf16(y[4], y[5]); o.w = cvt_pk_bf16(y[6], y[7]);
        *(u32x4*)(base + (ptrdiff_t)r * PW) = o;
#pragma unroll
        for (int c = 0; c < 8; ++c) { xp[c] = xc[c]; xc[c] = xn[c]; }
    }
}

template <bool TR>
DI void stage_plain(const bf16_t* Pb, int R0, int col0, LAS u8* dst, int tid) {
    const int cg = tid & 31, rg = tid >> 5; const int d0 = cg * 8, t0 = rg * 8;
    const bf16_t* base = Pb + (size_t)(R0 + t0) * PW + col0 + d0;
    u32x4 raw[8];
#pragma unroll
    for (int r = 0; r < 8; ++r) raw[r] = *(const u32x4*)(base + (size_t)r * PW);
    if (!TR) {
#pragma unroll
        for (int r = 0; r < 8; ++r) *(LAS u32x4*)(dst + (t0 + r) * 528 + d0 * 2) = raw[r];
    } else {
#pragma unroll
        for (int c = 0; c < 8; ++c) { u32x4 v; const int cw = c >> 1, hi = c & 1;
            v.x = half_sel(raw[0][cw], hi) | (half_sel(raw[1][cw], hi) << 16); v.y = half_sel(raw[2][cw], hi) | (half_sel(raw[3][cw], hi) << 16);
            v.z = half_sel(raw[4][cw], hi) | (half_sel(raw[5][cw], hi) << 16); v.w = half_sel(raw[6][cw], hi) | (half_sel(raw[7][cw], hi) << 16);
            *(LAS u32x4*)(dst + (d0 + c) * 272 + t0 * 2) = v; }
    }
}

struct GateScan { int t0, t1; float cb0, cb1, gi0, gi1; };
DI GateScan gate_scan(const float* G, int R0, int dir, int h, int lane) {
    GateScan r;
    const int p0 = 2 * lane, p1 = p0 + 1;
    r.t0 = dir ? 127 - p0 : p0; r.t1 = dir ? 127 - p1 : p1;
    const float* g0 = G + (size_t)(R0 + r.t0) * 16 + dir * 8 + h; const float* g1 = G + (size_t)(R0 + r.t1) * 16 + dir * 8 + h;
    r.gi0 = g0[0]; r.gi1 = g1[0];
    const float x0 = logsigf_(g0[4]), x1 = logsigf_(g1[4]);
    float s = x0 + x1;
#pragma unroll
    for (int o = 1; o < 64; o <<= 1) { const float v = __shfl_up(s, o); if (lane >= o) s += v; }
    r.cb1 = s; r.cb0 = s - x1;
    return r;
}

DI void task_m1(const Params& P, int l, int task, LAS u8* lds, const int tid0) {
    const int b = task >> 4, h = (task >> 2) & 3, dir = (task >> 1) & 1, sl = task & 1;
    LAS u8* QN = lds;
    LAS u8* CB = lds + 67584;
    LAS u8* WS16 = lds + 102400;
    LAS u8* NB = lds + 135168;
    LAS float* einter = (LAS float*)(lds + 143616); LAS float* wsv = einter + 128; LAS float* scal = wsv + 128;
    const bf16_t* Pb = (const bf16_t*)(P.ws + WS_P); const float* G = (const float*)(P.ws + WS_GATES);
    bf16_t* IM = (bf16_t*)(P.ws + WS_IM); float* MT = (float*)(P.ws + WS_MT); float* DEN = (float*)(P.ws + WS_DEN);
    f32x4 Cst[4][4]; f32x4 nacc[1][2];
#pragma unroll
    for (int i = 0; i < 4; ++i)
#pragma unroll
        for (int j = 0; j < 4; ++j) Cst[i][j] = (f32x4){0.f, 0.f, 0.f, 0.f};
    nacc[0][0] = (f32x4){0.f, 0.f, 0.f, 0.f}; nacc[0][1] = nacc[0][0];
    float m_prev = 0.f;
    u32x4 rq[8], rk[8], rv[4];
#define M1_R0(n_) (((n_) < 2) ? (MLAT + b * CTXL + (dir ? 1 - (n_) : (n_)) * 128) : (b * SEQ + (dir ? 31 - ((n_) - 2) : (n_) - 2) * 128))
    {
        const int R0 = M1_R0(0);
        const bf16_t* base = Pb + (size_t)(R0 + (tid0 >> 5) * 8) * PW + PC_BQ + h * 256 + (tid0 & 31) * 8;
#pragma unroll
        for (int r = 0; r < 8; ++r) rq[r] = *(const u32x4*)(base + (size_t)r * PW);
    }
    for (int i = tid0; i < 16 * 528 / 4; i += 512) ((LAS unsigned*)NB)[i] = 0u;
    __syncthreads();
#pragma unroll 1
    for (int n = 0; n < 34; ++n) {
        int tid = tid0; asm volatile("" : "+v"(tid));
        const int w = tid >> 6, lane = tid & 63, fr = lane & 15, fq = lane >> 4, wm = w >> 2, wn = w & 3;
        const int cg = tid & 31, rg = tid >> 5, cg16 = tid & 15, rg32 = tid >> 4;
        const int R0 = M1_R0(n);
#pragma unroll
        for (int r = 0; r < 8; ++r) *(LAS u32x4*)(QN + (rg * 8 + r) * 528 + cg * 16) = rq[r];
        __builtin_amdgcn_sched_barrier(0);
#pragma unroll
        for (int mt = 0; mt < 4; ++mt)
#pragma unroll
            for (int nt = 0; nt < 4; ++nt) { u32x2 pk; pk.x = cvt_pk_bf16(Cst[mt][nt][0], Cst[mt][nt][1]); pk.y = cvt_pk_bf16(Cst[mt][nt][2], Cst[mt][nt][3]);
                *(LAS u32x2*)(CB + (64 * wm + 32 * (mt >> 1) + 16 * ((fr >> 2) & 1) + 4 * (2 * (mt & 1) + (fr >> 3)) + (fr & 3)) * 528 + (64 * wn + nt * 16 + 4 * fq) * 2) = pk; }
        if (fr == 0) {
#pragma unroll
            for (int nt = 0; nt < 2; ++nt) { u32x2 pk; pk.x = cvt_pk_bf16(nacc[0][nt][0], nacc[0][nt][1]); pk.y = cvt_pk_bf16(nacc[0][nt][2], nacc[0][nt][3]);
                *(LAS u32x2*)(NB + (32 * w + nt * 16 + 4 * fq) * 2) = pk; }
        }
        if (w == 0) {
            const GateScan gs = gate_scan(G, R0, dir, h, lane);
            const float y0 = gs.gi0 - gs.cb0, y1 = gs.gi1 - gs.cb1;
            float incl = fmaxf(y0, y1);
#pragma unroll
            for (int o = 1; o < 64; o <<= 1) { const float v = __shfl_up(incl, o); if (lane >= o) incl = fmaxf(incl, v); }
            float excl = __shfl_up(incl, 1); if (lane == 0) excl = -3.0e38f;
            const float a0 = fmaxf(excl, y0), a1 = incl;
            const float mt0 = gs.cb0 + fmaxf(m_prev, a0), mt1 = gs.cb1 + fmaxf(m_prev, a1);
            const float cl = __shfl(gs.cb1, 63), amax = __shfl(a1, 63);
            const float m_new = cl + fmaxf(m_prev, amax);
            einter[gs.t0] = __expf(gs.cb0 + m_prev - mt0); einter[gs.t1] = __expf(gs.cb1 + m_prev - mt1);
            wsv[gs.t0] = __expf(cl - gs.cb0 + gs.gi0 - m_new); wsv[gs.t1] = __expf(cl - gs.cb1 + gs.gi1 - m_new);
            if (lane == 0) scal[0] = __expf(cl + m_prev - m_new);
            if (sl == 0) { MT[((size_t)dir * MTOT + R0 + gs.t0) * 4 + h] = mt0; MT[((size_t)dir * MTOT + R0 + gs.t1) * 4 + h] = mt1; }
            m_prev = m_new;
        }
        {
            const bf16_t* kb = Pb + (size_t)(R0 + rg * 8) * PW + PC_BK + h * 256 + cg * 8;
#pragma unroll
            for (int r = 0; r < 8; ++r) rk[r] = *(const u32x4*)(kb + (size_t)r * PW);
            const bf16_t* vb = Pb + (size_t)(R0 + rg32 * 4) * PW + PC_BV + h * 256 + sl * 128 + cg16 * 8;
#pragma unroll
            for (int r = 0; r < 4; ++r) rv[r] = *(const u32x4*)(vb + (size_t)r * PW);
        }
        __syncthreads();
        {
            f32x4 o[4][2];
#pragma unroll
            for (int i = 0; i < 4; ++i) { o[i][0] = (f32x4){0.f, 0.f, 0.f, 0.f}; o[i][1] = o[i][0]; }
            mma_tile<4, 2, 8, false, false>(QN, 528, 64 * wm, CB, 528, 32 * wn, o, lane);
            f32x4 on[1][1]; on[0][0] = (f32x4){0.f, 0.f, 0.f, 0.f};
            mma_tile<1, 1, 8, false, false>(QN, 528, 16 * w, NB, 528, 0, on, lane);
#pragma unroll
            for (int mt = 0; mt < 4; ++mt) { const int t = 64 * wm + mt * 16 + fr; const float ei = einter[t];
                bf16_t* dstp = IM + ((size_t)dir * MTOT + R0 + t) * 1024 + h * 256 + sl * 128 + 32 * wn + 8 * fq;
                u32x4 pk; pk.x = cvt_pk_bf16(o[mt][0][0] * ei, o[mt][0][1] * ei); pk.y = cvt_pk_bf16(o[mt][0][2] * ei, o[mt][0][3] * ei);
                pk.z = cvt_pk_bf16(o[mt][1][0] * ei, o[mt][1][1] * ei); pk.w = cvt_pk_bf16(o[mt][1][2] * ei, o[mt][1][3] * ei);
                *(u32x4*)(dstp) = pk; }
            if (sl == 0 && fq == 0) { const int t = 16 * w + fr; DEN[((size_t)dir * MTOT + R0 + t) * 4 + h] = einter[t] * on[0][0][0]; }
        }
        __syncthreads();
#pragma unroll
        for (int r = 0; r < 8; ++r) *(LAS u32x4*)(QN + (rg * 8 + r) * 528 + cg * 16) = rk[r];
#pragma unroll
        for (int r = 0; r < 4; ++r) { float v8[8]; unpack8(rv[r], v8); const float wv = wsv[rg32 * 4 + r];
            u32x4 ov; ov.x = cvt_pk_bf16(v8[0] * wv, v8[1] * wv); ov.y = cvt_pk_bf16(v8[2] * wv, v8[3] * wv); ov.z = cvt_pk_bf16(v8[4] * wv, v8[5] * wv); ov.w = cvt_pk_bf16(v8[6] * wv, v8[7] * wv);
            *(LAS u32x4*)(CB + (rg32 * 4 + r) * 272 + cg16 * 16) = ov; }
        if (tid < 128) { const unsigned wbits = cvt_pk_bf16(wsv[tid], 0.f);
            *(LAS u32x4*)(WS16 + tid * 48) = (u32x4){wbits, 0u, 0u, 0u}; *(LAS u32x4*)(WS16 + tid * 48 + 16) = (u32x4){0u, 0u, 0u, 0u}; }
        __syncthreads();
        {
            const float ec = scal[0];
#pragma unroll
            for (int i = 0; i < 4; ++i)
#pragma unroll
                for (int j = 0; j < 4; ++j) Cst[i][j] *= ec;
            nacc[0][0] *= ec; nacc[0][1] *= ec;
            mma_tile<4, 4, 4, true, true>(CB, 272, 64 * wm, QN, 528, 64 * wn, Cst, lane);
            mma_tile<1, 2, 4, true, true>(WS16, 48, 0, QN, 528, 32 * w, nacc, lane);
        }
        if (n + 1 < 34) {
            const int R1 = M1_R0(n + 1);
            const bf16_t* qb = Pb + (size_t)(R1 + rg * 8) * PW + PC_BQ + h * 256 + cg * 8;
#pragma unroll
            for (int r = 0; r < 8; ++r) rq[r] = *(const u32x4*)(qb + (size_t)r * PW);
        }
        __syncthreads();
    }
#undef M1_R0
}

DI void task_m2(const Params& P, int l, int b, int h, int cpos, LAS u8* lds, int tid) {
    LAS u8* R1 = lds; LAS u8* R2 = lds + 69632; LAS float* sm = (LAS float*)(lds + 139264);
    const bf16_t* Pb = (const bf16_t*)(P.ws + WS_P); const float* G = (const float*)(P.ws + WS_GATES); bf16_t* mix = (bf16_t*)(P.ws + WS_N);
    const bf16_t* IM = (const bf16_t*)(P.ws + WS_IM); const float* MT = (const float*)(P.ws + WS_MT); const float* DEN = (const float*)(P.ws + WS_DEN);
    const int w = tid >> 6, lane = tid & 63, fr = lane & 15, fq = lane >> 4;
    const int R0 = (cpos < 2) ? (MLAT + b * CTXL + cpos * 128) : (b * SEQ + (cpos - 2) * 128);
    if (w < 2) {
        const int dir = w; const GateScan gs = gate_scan(G, R0, dir, h, lane);
        LAS float* q = sm + dir * 512;
        q[gs.t0] = gs.cb0; q[gs.t1] = gs.cb1; q[128 + gs.t0] = gs.gi0 - gs.cb0; q[128 + gs.t1] = gs.gi1 - gs.cb1;
        q[256 + gs.t0] = MT[((size_t)dir * MTOT + R0 + gs.t0) * 4 + h]; q[256 + gs.t1] = MT[((size_t)dir * MTOT + R0 + gs.t1) * 4 + h];
        q[384 + gs.t0] = DEN[((size_t)dir * MTOT + R0 + gs.t0) * 4 + h]; q[384 + gs.t1] = DEN[((size_t)dir * MTOT + R0 + gs.t1) * 4 + h];
    }
    stage_plain<false>(Pb, R0, PC_BQ + h * 256, R1, tid);
    stage_plain<false>(Pb, R0, PC_BK + h * 256, R2, tid);
    __syncthreads();
    const int t = 16 * w + fr;
    float rNf, rNb;
    unsigned pp[8][2];
    {
        f32x4 s[8];
#pragma unroll
        for (int i = 0; i < 8; ++i) s[i] = (f32x4){0.f, 0.f, 0.f, 0.f};
        mma_rows<8, 8>(R1, 528, 16 * w, R2, 528, 0, s, fr, fq);
        const float cbf_t = sm[t], mtf_t = sm[256 + t], dnf_t = sm[384 + t], cbb_t = sm[512 + t], mtb_t = sm[768 + t], dnb_t = sm[896 + t];
        float vf[8][4], vb[8][4]; float sumf = 0.f, sumb = 0.f;
#pragma unroll
        for (int nt = 0; nt < 8; ++nt) { const f32x4 bif = *(const LAS f32x4*)(sm + 128 + nt * 16 + 4 * fq), bib = *(const LAS f32x4*)(sm + 640 + nt * 16 + 4 * fq);
#pragma unroll
            for (int j = 0; j < 4; ++j) { const int si = nt * 16 + 4 * fq + j;
                const float wf = __uint_as_float(__float_as_uint(__expf(cbf_t + bif[j] - mtf_t)) & ~(unsigned)((t - si) >> 31));
                const float wb = __uint_as_float(__float_as_uint(__expf(cbb_t + bib[j] - mtb_t)) & ~(unsigned)((si - t) >> 31));
                vf[nt][j] = s[nt][j] * wf; vb[nt][j] = s[nt][j] * wb; sumf += vf[nt][j]; sumb += vb[nt][j]; } }
        sumf += __shfl_xor(sumf, 16); sumf += __shfl_xor(sumf, 32); sumb += __shfl_xor(sumb, 16); sumb += __shfl_xor(sumb, 32);
        rNf = rcpf_(fmaxf(fabsf(sumf + dnf_t), __expf(-mtf_t))); rNb = rcpf_(fmaxf(fabsf(sumb + dnb_t), __expf(-mtb_t)));
#pragma unroll
        for (int nt = 0; nt < 8; ++nt) { pp[nt][0] = cvt_pk_bf16(vf[nt][0] * rNf + vb[nt][0] * rNb, vf[nt][1] * rNf + vb[nt][1] * rNb);
            pp[nt][1] = cvt_pk_bf16(vf[nt][2] * rNf + vb[nt][2] * rNb, vf[nt][3] * rNf + vb[nt][3] * rNb); }
    }
    __syncthreads();
#pragma unroll
    for (int nt = 0; nt < 8; ++nt) { u32x2 pk; pk.x = pp[nt][0]; pk.y = pp[nt][1]; *(LAS u32x2*)(R1 + t * 272 + (nt * 16 + 4 * fq) * 2) = pk; }
    {
        const int cg = tid & 31, rg = tid >> 5;
        const bf16_t* vp = Pb + (size_t)(R0 + rg * 8) * PW + PC_BV + h * 256 + cg * 8;
        u32x4 raw[8];
#pragma unroll
        for (int r = 0; r < 8; ++r) raw[r] = *(const u32x4*)(vp + (size_t)r * PW);
#pragma unroll
        for (int c = 0; c < 8; ++c) { u32x4 v; const int cw = c >> 1, hi = c & 1;
            v.x = half_sel(raw[0][cw], hi) | (half_sel(raw[1][cw], hi) << 16); v.y = half_sel(raw[2][cw], hi) | (half_sel(raw[3][cw], hi) << 16);
            v.z = half_sel(raw[4][cw], hi) | (half_sel(raw[5][cw], hi) << 16); v.w = half_sel(raw[6][cw], hi) | (half_sel(raw[7][cw], hi) << 16);
            *(LAS u32x4*)(R2 + (32 * (cg >> 2) + 16 * ((c >> 2) & 1) + 4 * (cg & 3) + (c & 3)) * 272 + (rg * 8) * 2) = v; }
    }
    __syncthreads();
    {
        f32x4 o[16];
#pragma unroll
        for (int i = 0; i < 16; ++i) o[i] = (f32x4){0.f, 0.f, 0.f, 0.f};
        mma_rows<16, 4>(R1, 272, 16 * w, R2, 272, 0, o, fr, fq);
        const size_t R = (size_t)(R0 + t);
        const bf16_t* imf = IM + R * 1024 + h * 256; const bf16_t* imb = IM + ((size_t)MTOT + R) * 1024 + h * 256;
        float ssq = 0.f;
#pragma unroll
        for (int gp = 0; gp < 8; ++gp) { const int e = gp * 32 + 8 * fq;
            const u32x4 a = *(const u32x4*)(imf + e), c = *(const u32x4*)(imb + e);
            float af[8], cf[8]; unpack8(a, af); unpack8(c, cf);
#pragma unroll
            for (int j = 0; j < 4; ++j) { o[2 * gp][j] += af[j] * rNf + cf[j] * rNb; o[2 * gp + 1][j] += af[4 + j] * rNf + cf[4 + j] * rNb;
                ssq += o[2 * gp][j] * o[2 * gp][j] + o[2 * gp + 1][j] * o[2 * gp + 1][j]; } }
        ssq += __shfl_xor(ssq, 16); ssq += __shfl_xor(ssq, 32);
        const float rstd = rsqrtf(ssq * (1.0f / 256.0f) + EPS);
        const float* mg = P.in[12] + l * 1024 + h * 256;
#pragma unroll
        for (int gp = 0; gp < 8; ++gp) { const int e = gp * 32 + 8 * fq;
            const f32x4 g0 = *(const f32x4*)(mg + e), g1 = *(const f32x4*)(mg + e + 4);
            const u32x4 bo = *(const u32x4*)(Pb + R * PW + PC_BO + h * 256 + e), bz = *(const u32x4*)(Pb + R * PW + PC_BZ + h * 256 + e);
            float bof[8], bzf[8]; unpack8(bo, bof); unpack8(bz, bzf);
            float y[8];
#pragma unroll
            for (int j = 0; j < 4; ++j) { y[j] = o[2 * gp][j] * rstd * g0[j] * sigmoidf_(bof[j]) * siluf_(bzf[j]); y[4 + j] = o[2 * gp + 1][j] * rstd * g1[j] * sigmoidf_(bof[4 + j]) * siluf_(bzf[4 + j]); }
            u32x4 pk; pk.x = cvt_pk_bf16(y[0], y[1]); pk.y = cvt_pk_bf16(y[2], y[3]); pk.z = cvt_pk_bf16(y[4], y[5]); pk.w = cvt_pk_bf16(y[6], y[7]);
            *(u32x4*)(mix + R * DM + 512 + h * 256 + e) = pk; }
    }
    __syncthreads();
}

DI void hgrn_gate16(const u32x4 z0, const u32x4 z1, const float (&lbv)[16], float (&kk)[16], LAS float* lfrow) {
    float z[16]; { float a[8], b[8]; unpack8(z0, a); unpack8(z1, b);
#pragma unroll
        for (int j = 0; j < 8; ++j) { z[j] = a[j]; z[8 + j] = b[j]; } }
    float lf[16];
#pragma unroll
    for (int j = 0; j < 16; ++j) { const float f = fmaxf(lbv[j] + (1.0f - lbv[j]) * sigmoidf_(z[j]), 1e-30f); lf[j] = __logf(f); kk[j] = 1.0f - f; }
#pragma unroll
    for (int j = 0; j < 4; ++j) *(LAS f32x4*)(lfrow + 4 * j) = (f32x4){lf[4 * j], lf[4 * j + 1], lf[4 * j + 2], lf[4 * j + 3]};
}

DI void task_hpre(const Params& P, int l, int b, int hd, int cpos, LAS u8* lds, int tid) {
    LAS float* lf = (LAS float*)lds; LAS u8* qd = lds + 32768; LAS u8* kd = lds + 50176; LAS u8* vN = lds + 67584; LAS u8* Pm = lds + 84992; LAS float* tot = (LAS float*)(lds + 94208);
    bf16_t* Pb = (bf16_t*)(P.ws + WS_P); bf16_t* OI = (bf16_t*)(P.ws + WS_OI); bf16_t* QB = (bf16_t*)(P.ws + WS_QB);
    float* DEC = (float*)(P.ws + WS_DEC) + (size_t)(((b * 4 + hd) * 68 + cpos) * 2) * 128;
    const float* lb = (const float*)(P.ws + WS_LB) + l * 512 + hd * 128;
    const int w = tid >> 6, lane = tid & 63, fr = lane & 15, fq = lane >> 4;
    const int i = tid >> 3, cg = tid & 7, c0 = cg * 16;
    int rbase, rstride;
    if (cpos < 4) { rbase = MLAT + b * CTXL + cpos * 64; rstride = 1; } else { rbase = b * SEQ + (cpos - 4); rstride = 64; }
    float lbv[16];
#pragma unroll
    for (int j = 0; j < 16; ++j) lbv[j] = lb[c0 + j];
    bf16_t* prow = Pb + (size_t)(rbase + i * rstride) * PW + hd * 128 + c0;
    float q[16];
    { const u32x4 q0 = *(const u32x4*)(prow + PC_CQ), q1 = *(const u32x4*)(prow + PC_CQ + 8); float a[8], c[8]; unpack8(q0, a); unpack8(q1, c);
#pragma unroll
        for (int j = 0; j < 8; ++j) { q[j] = siluf_(a[j]); q[8 + j] = siluf_(c[j]); } }
    { const u32x4 v0 = *(const u32x4*)(prow + PC_CI), v1 = *(const u32x4*)(prow + PC_CI + 8);
        *(LAS u32x4*)(vN + i * 272 + c0 * 2) = v0; *(LAS u32x4*)(vN + i * 272 + c0 * 2 + 16) = v1; }
    const u32x4 zf0 = *(const u32x4*)(prow + PC_CFF), zf1 = *(const u32x4*)(prow + PC_CFF + 8);
    const u32x4 zb0 = *(const u32x4*)(prow + PC_CFB), zb1 = *(const u32x4*)(prow + PC_CFB + 8);
    f32x4 sc[2]; sc[0] = (f32x4){0.f, 0.f, 0.f, 0.f}; sc[1] = sc[0];
    const int ii = 16 * (w >> 1) + fr;
#pragma unroll 1
    for (int d = 0; d < 2; ++d) {
        float kk[16];
        hgrn_gate16(d ? zb0 : zf0, d ? zb1 : zf1, lbv, kk, lf + i * 128 + c0);
        __syncthreads();
        {
            const int c = tid & 127, part = tid >> 7;
            float x[16];
#pragma unroll
            for (int k = 0; k < 16; ++k) { const int sidx = part * 16 + k; const int i2 = d ? 63 - sidx : sidx; x[k] = lf[i2 * 128 + c]; }
#pragma unroll
            for (int k = 1; k < 16; ++k) x[k] += x[k - 1];
            tot[part * 128 + c] = x[15];
            __syncthreads();
            float off = 0.f;
#pragma unroll
            for (int pp = 0; pp < 3; ++pp) off += (pp < part) ? tot[pp * 128 + c] : 0.f;
#pragma unroll
            for (int k = 0; k < 16; ++k) { const int sidx = part * 16 + k; const int i2 = d ? 63 - sidx : sidx; lf[i2 * 128 + c] = x[k] + off; }
            if (part == 3) DEC[d * 128 + c] = __expf(x[15] + off);
        }
        __syncthreads();
        {
            const int ilast = d ? 0 : 63;
            unsigned qo[8], ko[8], qs[8], ks[8];
#pragma unroll
            for (int j = 0; j < 16; j += 2) {
                const float cb0 = lf[i * 128 + c0 + j], cb1 = lf[i * 128 + c0 + j + 1], rf0 = lf[32 * 128 + c0 + j], rf1 = lf[32 * 128 + c0 + j + 1];
                const float cl0 = lf[ilast * 128 + c0 + j], cl1 = lf[ilast * 128 + c0 + j + 1];
                qo[j >> 1] = cvt_pk_bf16(q[j] * __expf(cb0 - rf0), q[j + 1] * __expf(cb1 - rf1));
                ko[j >> 1] = cvt_pk_bf16(kk[j] * __expf(rf0 - cb0), kk[j + 1] * __expf(rf1 - cb1));
                qs[j >> 1] = cvt_pk_bf16(q[j] * __expf(cb0), q[j + 1] * __expf(cb1));
                ks[j >> 1] = cvt_pk_bf16(kk[j] * __expf(cl0 - cb0), kk[j + 1] * __expf(cl1 - cb1)); }
            *(LAS u32x4*)(qd + i * 272 + c0 * 2) = (u32x4){qo[0], qo[1], qo[2], qo[3]}; *(LAS u32x4*)(qd + i * 272 + c0 * 2 + 16) = (u32x4){qo[4], qo[5], qo[6], qo[7]};
            *(LAS u32x4*)(kd + i * 272 + c0 * 2) = (u32x4){ko[0], ko[1], ko[2], ko[3]}; *(LAS u32x4*)(kd + i * 272 + c0 * 2 + 16) = (u32x4){ko[4], ko[5], ko[6], ko[7]};
            bf16_t* qdst = d ? QB + (size_t)(rbase + i * rstride) * 512 + hd * 128 + c0 : prow + PC_CQ;
            bf16_t* kdst = prow + (d ? PC_CFB : PC_CFF);
            *(u32x4*)(qdst) = (u32x4){qs[0], qs[1], qs[2], qs[3]}; *(u32x4*)(qdst + 8) = (u32x4){qs[4], qs[5], qs[6], qs[7]};
            *(u32x4*)(kdst) = (u32x4){ks[0], ks[1], ks[2], ks[3]}; *(u32x4*)(kdst + 8) = (u32x4){ks[4], ks[5], ks[6], ks[7]};
        }
        __syncthreads();
        {
            f32x4 s2[2]; s2[0] = (f32x4){0.f, 0.f, 0.f, 0.f}; s2[1] = s2[0];
            mma_rows<2, 4>(qd, 272, 16 * (w >> 1), kd, 272, 32 * (w & 1), s2, fr, fq);
#pragma unroll
            for (int nt = 0; nt < 2; ++nt)
#pragma unroll
                for (int j = 0; j < 4; ++j) { const int jj = 32 * (w & 1) + nt * 16 + 4 * fq + j; const int df = d ? (jj - ii) : (ii - jj); sc[nt][j] += __uint_as_float(__float_as_uint(s2[nt][j]) & ~(unsigned)(df >> 31)); }
        }
        __syncthreads();
    }
#pragma unroll
    for (int nt = 0; nt < 2; ++nt) { u32x2 pk; pk.x = cvt_pk_bf16(sc[nt][0], sc[nt][1]); pk.y = cvt_pk_bf16(sc[nt][2], sc[nt][3]);
        *(LAS u32x2*)(Pm + ii * 144 + (32 * (w & 1) + nt * 16 + 4 * fq) * 2) = pk; }
    __syncthreads();
    {
        f32x4 o[4];
#pragma unroll
        for (int j = 0; j < 4; ++j) o[j] = (f32x4){0.f, 0.f, 0.f, 0.f};
        mma_gen<4, 2, false, true>(Pm, 144, 16 * (w & 3), vN, 272, 64 * (w >> 2), o, lane);
        const int io = 16 * (w & 3) + fr; const size_t Ro = (size_t)(rbase + io * rstride);
        bf16_t* dstp = OI + Ro * 512 + hd * 128 + 64 * (w >> 2);
#pragma unroll
        for (int nt = 0; nt < 4; ++nt) { u32x2 pk; pk.x = cvt_pk_bf16(o[nt][0], o[nt][1]); pk.y = cvt_pk_bf16(o[nt][2], o[nt][3]); *(u32x2*)(dstp + nt * 16 + 4 * fq) = pk; }
    }
    __syncthreads();
}

DI void task_h1(const Params& P, int l, int task, LAS u8* lds, const int tid0) {
    const int b = task >> 3, hd = (task >> 1) & 3, dir = task & 1;
    LAS u8* qh = lds; LAS u8* kh = lds + 17408; LAS u8* vN = lds + 34816; LAS u8* SB = lds + 52224;
    const bf16_t* Pb = (const bf16_t*)(P.ws + WS_P); const bf16_t* QB = (const bf16_t*)(P.ws + WS_QB); bf16_t* IH = (bf16_t*)(P.ws + WS_IH);
    const float* DECb = (const float*)(P.ws + WS_DEC) + (size_t)((b * 4 + hd) * 68) * 256 + dir * 128;
    f32x4 st[8];
#pragma unroll
    for (int j = 0; j < 8; ++j) st[j] = (f32x4){0.f, 0.f, 0.f, 0.f};
    u32x4 rq0, rq1, rk0, rk1, rv0, rv1; f32x4 dc[8];
#define H1_LOAD(n_) do { const int n__ = (n_); int rb_, rs_, cp_; \
        if (n__ < 4) { const int cc = dir ? 3 - n__ : n__; rb_ = MLAT + b * CTXL + cc * 64; rs_ = 1; cp_ = cc; } \
        else { const int wc = dir ? 63 - (n__ - 4) : n__ - 4; rb_ = b * SEQ + wc; rs_ = 64; cp_ = 4 + wc; } \
        const int i_ = tid0 >> 3, c0_ = (tid0 & 7) * 16; const size_t R_ = (size_t)(rb_ + i_ * rs_); \
        const bf16_t* pr_ = Pb + R_ * PW + hd * 128 + c0_; \
        const bf16_t* qp_ = dir ? QB + R_ * 512 + hd * 128 + c0_ : pr_ + PC_CQ; \
        rq0 = *(const u32x4*)(qp_); rq1 = *(const u32x4*)(qp_ + 8); \
        rk0 = *(const u32x4*)(pr_ + (dir ? PC_CFB : PC_CFF)); rk1 = *(const u32x4*)(pr_ + (dir ? PC_CFB : PC_CFF) + 8); \
        rv0 = *(const u32x4*)(pr_ + PC_CI); rv1 = *(const u32x4*)(pr_ + PC_CI + 8); \
        const int fq_ = (tid0 & 63) >> 4; \
        _Pragma("unroll") for (int nt = 0; nt < 8; ++nt) dc[nt] = *(const f32x4*)(DECb + (size_t)cp_ * 256 + nt * 16 + 4 * fq_); } while (0)
    H1_LOAD(0);
#pragma unroll 1
    for (int n = 0; n < 68; ++n) {
        int tid = tid0; asm volatile("" : "+v"(tid));
        const int w = tid >> 6, lane = tid & 63, fr = lane & 15, fq = lane >> 4;
        const int i = tid >> 3, c0 = (tid & 7) * 16;
        int rbase, rstride;
        if (n < 4) { const int cc = dir ? 3 - n : n; rbase = MLAT + b * CTXL + cc * 64; rstride = 1; }
        else { const int wc = dir ? 63 - (n - 4) : n - 4; rbase = b * SEQ + wc; rstride = 64; }
        *(LAS u32x4*)(qh + i * 272 + c0 * 2) = rq0; *(LAS u32x4*)(qh + i * 272 + c0 * 2 + 16) = rq1;
        *(LAS u32x4*)(kh + i * 272 + c0 * 2) = rk0; *(LAS u32x4*)(kh + i * 272 + c0 * 2 + 16) = rk1;
        *(LAS u32x4*)(vN + i * 272 + c0 * 2) = rv0; *(LAS u32x4*)(vN + i * 272 + c0 * 2 + 16) = rv1;
        {
            const int e = 32 * (w >> 1) + 16 * ((fr >> 2) & 1) + 4 * (2 * (w & 1) + (fr >> 3)) + (fr & 3);
#pragma unroll
            for (int nt = 0; nt < 8; ++nt) { u32x2 pk; pk.x = cvt_pk_bf16(st[nt][0], st[nt][1]); pk.y = cvt_pk_bf16(st[nt][2], st[nt][3]);
                *(LAS u32x2*)(SB + e * 272 + (nt * 16 + 4 * fq) * 2) = pk; }
        }
        f32x4 dcur[8];
#pragma unroll
        for (int nt = 0; nt < 8; ++nt) dcur[nt] = dc[nt];
        if (n + 1 < 68) H1_LOAD(n + 1);
        __syncthreads();
        {
            f32x4 o[4];
#pragma unroll
            for (int j = 0; j < 4; ++j) o[j] = (f32x4){0.f, 0.f, 0.f, 0.f};
            mma_rows<4, 4>(qh, 272, 16 * (w & 3), SB, 272, 64 * (w >> 2), o, fr, fq);
            const int io = 16 * (w & 3) + fr;
            bf16_t* dstp = IH + ((size_t)dir * MTOT + rbase + io * rstride) * 512 + hd * 128 + 64 * (w >> 2);
#pragma unroll
            for (int gp = 0; gp < 2; ++gp) { u32x4 pk; pk.x = cvt_pk_bf16(o[2 * gp][0], o[2 * gp][1]); pk.y = cvt_pk_bf16(o[2 * gp][2], o[2 * gp][3]);
                pk.z = cvt_pk_bf16(o[2 * gp + 1][0], o[2 * gp + 1][1]); pk.w = cvt_pk_bf16(o[2 * gp + 1][2], o[2 * gp + 1][3]); *(u32x4*)(dstp + gp * 32 + 8 * fq) = pk; }
#pragma unroll
            for (int nt = 0; nt < 8; ++nt) st[nt] *= dcur[nt];
            mma_gen<8, 2, true, true>(vN, 272, 16 * w, kh, 272, 0, st, lane);
        }
        __syncthreads();
    }
#undef H1_LOAD
}

DI void phase_hpost(const Params& P, int l, int nrows, int tid, int bfirst, int nblk) {
    const bf16_t* Pb = (const bf16_t*)(P.ws + WS_P); const bf16_t* IH = (const bf16_t*)(P.ws + WS_IH); const bf16_t* OI = (const bf16_t*)(P.ws + WS_OI);
    bf16_t* mix = (bf16_t*)(P.ws + WS_N);
    const int w = tid >> 6, lane = tid & 63;
    const float* hg = P.in[14] + l * 512 + lane * 8;
    const f32x4 g0 = *(const f32x4*)(hg), g1 = *(const f32x4*)(hg + 4);
    if ((int)blockIdx.x < bfirst) return;
    for (int R = ((int)blockIdx.x - bfirst) * 8 + w; R < nrows; R += nblk * 8) {
        const u32x4 a = __builtin_nontemporal_load((const u32x4*)(OI + (size_t)R * 512 + lane * 8)), f = __builtin_nontemporal_load((const u32x4*)(IH + (size_t)R * 512 + lane * 8)), bb = __builtin_nontemporal_load((const u32x4*)(IH + ((size_t)MTOT + R) * 512 + lane * 8));
        const u32x4 gz = __builtin_nontemporal_load((const u32x4*)(Pb + (size_t)R * PW + PC_CG + lane * 8));
        float x[8], y[8], z[8], gg[8]; unpack8(a, x); unpack8(f, y); unpack8(bb, z); unpack8(gz, gg);
        float ssq = 0.f;
#pragma unroll
        for (int j = 0; j < 8; ++j) { x[j] += y[j] + z[j]; ssq += x[j] * x[j]; }
        ssq += __shfl_xor(ssq, 1); ssq += __shfl_xor(ssq, 2); ssq += __shfl_xor(ssq, 4); ssq += __shfl_xor(ssq, 8);
        const float rstd = rsqrtf(ssq * (1.0f / 128.0f) + EPS);
        u32x4 o;
        o.x = cvt_pk_bf16(x[0] * rstd * g0[0] * siluf_(gg[0]), x[1] * rstd * g0[1] * siluf_(gg[1]));
        o.y = cvt_pk_bf16(x[2] * rstd * g0[2] * siluf_(gg[2]), x[3] * rstd * g0[3] * siluf_(gg[3]));
        o.z = cvt_pk_bf16(x[4] * rstd * g1[0] * siluf_(gg[4]), x[5] * rstd * g1[1] * siluf_(gg[5]));
        o.w = cvt_pk_bf16(x[6] * rstd * g1[2] * siluf_(gg[6]), x[7] * rstd * g1[3] * siluf_(gg[7]));
        *(u32x4*)(mix + (size_t)R * DM + 1536 + lane * 8) = o;
    }
}

DI void phase_final(const Params& P, int tid) {
    const float* fg = P.in[16]; float* out = P.out; const bf16_t* hf = (const bf16_t*)(P.ws + WS_P);
    const int w = tid >> 6, lane = tid & 63;
    f32x4 g[8];
#pragma unroll
    for (int i = 0; i < 8; ++i) g[i] = *(const f32x4*)(fg + (i * 64 + lane) * 4);
    for (int row = blockIdx.x * 8 + w; row < MLAT; row += gridDim.x * 8) {
        float* p = out + (size_t)row * DM; const bf16_t* ph = hf + (size_t)row * DM;
        f32x4 x[8]; float ss = 0.f;
#pragma unroll
        for (int i = 0; i < 8; ++i) { const u32x2 r2 = __builtin_nontemporal_load((const u32x2*)(ph + (i * 64 + lane) * 4)); x[i] = (f32x4){bf_lo(r2.x), bf_hi(r2.x), bf_lo(r2.y), bf_hi(r2.y)}; ss += x[i][0] * x[i][0] + x[i][1] * x[i][1] + x[i][2] * x[i][2] + x[i][3] * x[i][3]; }
#pragma unroll
        for (int o = 32; o >= 1; o >>= 1) ss += __shfl_xor(ss, o);
        const float rstd = rsqrtf(ss * (1.0f / DM) + EPS);
#pragma unroll
        for (int i = 0; i < 8; ++i) *(f32x4*)(p + (i * 64 + lane) * 4) = x[i] * rstd * g[i];
    }
}

DI void grid_bar(unsigned* cnt, unsigned target) {
    asm volatile("s_waitcnt vmcnt(0) lgkmcnt(0)" ::: "memory");
    __syncthreads();
    if (threadIdx.x < 64) {
        __builtin_amdgcn_fence(__ATOMIC_RELEASE, "agent");
        if (threadIdx.x == 0) {
            __hip_atomic_fetch_add(cnt, 1u, __ATOMIC_RELAXED, __HIP_MEMORY_SCOPE_AGENT);
            while (__hip_atomic_load(cnt, __ATOMIC_RELAXED, __HIP_MEMORY_SCOPE_AGENT) < target) __builtin_amdgcn_s_sleep(1);
        }
        __builtin_amdgcn_fence(__ATOMIC_ACQUIRE, "agent");
        asm volatile("s_waitcnt vmcnt(0)" ::: "memory");
    }
    __syncthreads();
}
DI unsigned xcc_id() { return (unsigned)__builtin_amdgcn_s_getreg((3 << 11) | 20) & 0xFu; }
DI void xcd_bar(unsigned* bar, unsigned nb, unsigned xcc, unsigned xcnt, unsigned nxcc) {
    asm volatile("s_waitcnt vmcnt(0) lgkmcnt(0)" ::: "memory");
    __syncthreads();
    if (threadIdx.x < 64) {
        if (threadIdx.x == 0) {
            const unsigned old = __hip_atomic_fetch_add(bar + 640 + 64 * xcc, 1u, __ATOMIC_RELAXED, __HIP_MEMORY_SCOPE_AGENT);
            if (old + 1u == nb * xcnt) {
                __builtin_amdgcn_fence(__ATOMIC_RELEASE, "agent");
                asm volatile("s_waitcnt vmcnt(0)" ::: "memory");
                __hip_atomic_fetch_add(bar + 1216, 1u, __ATOMIC_RELAXED, __HIP_MEMORY_SCOPE_AGENT);
            }
            unsigned spins = 0;
            while (__hip_atomic_load(bar + 1216, __ATOMIC_RELAXED, __HIP_MEMORY_SCOPE_AGENT) < nb * nxcc && ++spins < (1u << 22)) __builtin_amdgcn_s_sleep(6);
        }
        __builtin_amdgcn_fence(__ATOMIC_ACQUIRE, "agent");
        asm volatile("s_waitcnt vmcnt(0)" ::: "memory");
    }
    __syncthreads();
}
typedef const __attribute__((address_space(4))) Params* KargP;
#if defined(__HIP_DEVICE_COMPILE__)
DI Params fresh_params() { KargP pp = (KargP)__builtin_amdgcn_kernarg_segment_ptr(); asm volatile("" : "+s"(pp)); Params r;
#pragma unroll
    for (int i = 0; i < 17; ++i) r.in[i] = pp->in[i];
    r.out = pp->out; r.ws = pp->ws; return r; }
#else
DI Params fresh_params() { return Params{}; }
#endif

__global__ void __launch_bounds__(512, 2) mega_fwd(Params Pk) {
    extern __shared__ __attribute__((aligned(16))) u8 lds_raw[];
    LAS u8* lds = (LAS u8*)lds_raw;
    cg::grid_group grid = cg::this_grid();
    const int G = gridDim.x;
    unsigned nbar = 0;
    grid.sync();
    unsigned my_xcc, my_xcnt, n_xcc;
    {
        const Params Pb_ = fresh_params(); unsigned* bar = (unsigned*)(Pb_.ws + WS_BAR);
        my_xcc = __builtin_amdgcn_readfirstlane(xcc_id()) & 7u;
        if (threadIdx.x == 0) __hip_atomic_fetch_add(bar + 64 + 64 * my_xcc, 1u, __ATOMIC_RELAXED, __HIP_MEMORY_SCOPE_AGENT);
        grid_bar(bar, (unsigned)G);
        my_xcnt = __hip_atomic_load(bar + 64 + 64 * my_xcc, __ATOMIC_RELAXED, __HIP_MEMORY_SCOPE_AGENT);
        n_xcc = 0;
        for (int j = 0; j < 8; ++j) n_xcc += (__hip_atomic_load(bar + 64 + 64 * j, __ATOMIC_RELAXED, __HIP_MEMORY_SCOPE_AGENT) != 0u) ? 1u : 0u;
    }
#define GRID_SYNC() do { const Params Pb_ = fresh_params(); ++nbar; xcd_bar((unsigned*)(Pb_.ws + WS_BAR), nbar, my_xcc, my_xcnt, n_xcc); } while (0)
#define FRESH_TID int tid = threadIdx.x; asm volatile("" : "+v"(tid))

    { FRESH_TID; const Params P = fresh_params(); phase0(P, lds, tid); }
    GRID_SYNC();
#pragma unroll 1
    for (int l = 0; l < DEPTH; ++l) {
        const bool last = (l == DEPTH - 1);
        { FRESH_TID; const Params P = fresh_params(); phase1(P, l, lds, tid); }
        GRID_SYNC();
        {
            FRESH_TID; const Params P = fresh_params();
            pg8::Gemm g{(const bf16_t*)(P.ws + WS_N), (const bf16_t*)(P.ws + WS_WIN), MTOT, NGEMM, DM};
            pg8::StaticOrder S; S.init(MTOT, NGEMM, G, (int)blockIdx.x, P2_WGM);
            pg8::EpiP E{(bf16_t*)(P.ws + WS_P), (float*)(P.ws + WS_GATES), P.in[8] + (size_t)l * DIN, (bf16_t*)(P.ws + WS_HALO)};
            pg8::gemm_phase<pg8::EpiP>(lds, g, S, E, tid);
        }
        GRID_SYNC();
        {
            FRESH_TID; const Params P = fresh_params();
            const int n_pre = (G == 256) ? 1472 : 2176;
            for (int task = blockIdx.x; task < n_pre + 272 * 8; task += G) {
                int tl = tid; asm volatile("" : "+v"(tl));
                if (task < n_pre) task_hpre(P, l, task / 272, (task / 68) & 3, task % 68, lds, tl);
                else { const int a = task - n_pre; task_conv(P, l, a >> 3, (a >> 2) & 1, a & 3, tl); }
            }
        }
        GRID_SYNC();
        {
            FRESH_TID; const Params P = fresh_params();
            const int nA = last ? 1024 : 1088;
            const int bx = blockIdx.x;
            if (G == 256) {
                if (bx < 128) { int tl = tid; asm volatile("" : "+v"(tl)); task_m1(P, l, bx, lds, tl); }
                else {
                    const int hb = bx - 128;
                    {
                        const int t_first = (hb < 64) ? 1472 + hb : 1472 + 256 + (hb - 64), t_cnt = (hb < 64) ? 4 : 7;
                        for (int k = 0; k < t_cnt; ++k) { const int t2 = t_first + 64 * k; int tl = tid; asm volatile("" : "+v"(tl)); task_hpre(P, l, t2 / 272, (t2 / 68) & 3, t2 % 68, lds, tl); }
                    }
                    grid_bar((unsigned*)(P.ws + WS_BAR + 6144), (unsigned)(l + 1) * 128u);
                    if (hb < 64) { int tl = tid; asm volatile("" : "+v"(tl)); task_h1(P, l, hb, lds, tl); }
                    else { for (int a = hb - 64; a < nA; a += 64) { int tl = tid; asm volatile("" : "+v"(tl)); task_chunkmlp(P, l, a >> 2, a & 3, lds, tl); } }
                }
            }
            else if (bx < 128 && G >= 192) { int tl = tid; asm volatile("" : "+v"(tl)); task_m1(P, l, bx, lds, tl); }
            else {
                if (G < 192) { for (int t2 = bx; t2 < 128; t2 += G) { int tl = tid; asm volatile("" : "+v"(tl)); task_m1(P, l, t2, lds, tl); } }
                const int hb = (G >= 192) ? bx - 128 : bx, hs = (G >= 192) ? G - 128 : G;
                for (int t2 = hb; t2 < 64; t2 += hs) { int tl = tid; asm volatile("" : "+v"(tl)); task_h1(P, l, t2, lds, tl); }
                for (int a = hb; a < nA; a += hs) { int tl = tid; asm volatile("" : "+v"(tl)); task_chunkmlp(P, l, a >> 2, a & 3, lds, tl); }
            }
        }
        GRID_SYNC();
        {
            FRESH_TID; const Params P = fresh_params();
            const int nM2 = last ? 1024 : 1088;
            for (int task = blockIdx.x; task < nM2; task += G) {
                int tl = tid; asm volatile("" : "+v"(tl));
                int b, h, cpos;
                if (last) { cpos = 2 + (task & 31); h = (task >> 5) & 3; b = task >> 7; } else { cpos = task % 34; h = (task / 34) & 3; b = task / 136; }
                task_m2(P, l, b, h, cpos, lds, tl);
            }
            {
                const int nfull = nM2 % G; const int bfirst = (nfull > 0 && nfull < G) ? nfull : 0;
                phase_hpost(P, l, last ? MLAT : MTOT, tid, bfirst, G - bfirst);
            }
        }
        GRID_SYNC();
        {
            FRESH_TID; const Params P = fresh_params();
            const int M = last ? MLAT : MTOT;
            pg8::Gemm g{(const bf16_t*)(P.ws + WS_N), (const bf16_t*)(P.ws + WS_WOUT), M, DM, DM};
            pg8::StaticOrder S; S.init(M, DM, G, (int)blockIdx.x, 4);
            pg8::EpiH E{P.in[0], (bf16_t*)P.out, (bf16_t*)(P.ws + WS_P), l == 0 ? P.in[2] : (const float*)(P.ws + WS_HCTX), (float*)(P.ws + WS_HCTX),
                        (const float*)(P.ws + WS_MOD) + (size_t)l * 9 * 6144, l == 0 ? 1 : 0, last ? 1 : 0};
            pg8::gemm_phase<pg8::EpiH>(lds, g, S, E, tid);
        }
        GRID_SYNC();
    }
    { FRESH_TID; const Params P = fresh_params(); phase_final(P, tid); }
}

extern "C" void kernel_launch(void* const* d_in, const int* in_sizes, int n_in, void* d_out, int out_size, void* d_ws, size_t ws_size, hipStream_t stream) {
    static int grid_blocks = 0;
    if (grid_blocks == 0) {
        if (ws_size < WS_END) { fprintf(stderr, "kernel_launch: workspace too small: %zu < %zu\n", ws_size, (size_t)WS_END); grid_blocks = -1; return; }
        int dev = 0, cus = 0, per_cu = 0;
        (void)hipGetDevice(&dev);
        (void)hipDeviceGetAttribute(&cus, hipDeviceAttributeMultiprocessorCount, dev);
        if (hipFuncSetAttribute((const void*)mega_fwd, hipFuncAttributeMaxDynamicSharedMemorySize, LDS_BYTES) != hipSuccess) { fprintf(stderr, "kernel_launch: hipFuncSetAttribute failed\n"); grid_blocks = -1; return; }
        if (hipOccupancyMaxActiveBlocksPerMultiprocessor(&per_cu, (const void*)mega_fwd, 512, LDS_BYTES) != hipSuccess || per_cu < 1) { fprintf(stderr, "kernel_launch: occupancy query says %d\n", per_cu); per_cu = 1; }
        (void)hipGetLastError();
        grid_blocks = cus * per_cu;
    }
    if (grid_blocks < 0) return;
    (void)hipMemsetAsync((u8*)d_ws + WS_BAR, 0, 8192, stream);
    Params p{};
    for (int i = 0; i < 17; ++i) p.in[i] = (const float*)d_in[i];
    p.out = (float*)d_out; p.ws = (u8*)d_ws;
    void* args[] = {&p};
    hipError_t e = hipLaunchCooperativeKernel((const void*)mega_fwd, dim3(grid_blocks), dim3(512), args, LDS_BYTES, stream);
    if (e != hipSuccess) fprintf(stderr, "cooperative launch failed: %s (grid %d)\n", hipGetErrorString(e), grid_blocks);
}
```
